# Optimizing an MI355X kernel written in HIP

```python
import math
import jax, jax.numpy as jnp
from jax import lax
import numpy as np

D_MODEL = 1024
BATCH = 4
SEQ = 4096
DEPTH = 4

HEAD_DIM = 64
BLOCK = 128
A_HEADS = 8
A_KV = 2
WINDOW = 128
B_HEADS = 8
B_KV = 2
GRID_W = 64
C_WIDTH = 512
C_GROUPS = 4
C_GROUP_DIM = C_WIDTH // C_GROUPS
CHUNK = 128
N_BRANCH = 3
BRANCH_WIDTH = 512
ROPE_THETA = 10000.0
MEM_LEN = 256
X_HEADS = 4
X_HEAD_DIM = 128
X_WIDTH = X_HEADS * X_HEAD_DIM
D_FF = 2816
CONV_W = 3
ALPHA = (2 * DEPTH) ** 0.25
BETA = (8 * DEPTH) ** -0.25
LN_EPS = 1e-5
RMS_EPS = 1e-6

A_Q_W = A_HEADS * HEAD_DIM
A_KV_W = A_KV * HEAD_DIM
B_Q_W = B_HEADS * HEAD_DIM
B_KV_W = B_KV * HEAD_DIM
IN_SIZES = (A_Q_W, A_KV_W, A_KV_W, B_Q_W, B_KV_W, B_KV_W, 2 * C_WIDTH, N_BRANCH * D_MODEL)
D_IN = sum(IN_SIZES)

kernel_name = "hybrid_gated_window_axial_gmlp_encoder"


def _split_points(sizes):
    pts, acc = [], 0
    for s in sizes[:-1]:
        acc += s
        pts.append(acc)
    return pts


def layer_norm(x, g, b):
    xf = x.astype(jnp.float32)
    mu = jnp.mean(xf, axis=-1, keepdims=True)
    var = jnp.mean(jnp.square(xf - mu), axis=-1, keepdims=True)
    y = (xf - mu) * lax.rsqrt(var + LN_EPS) * g.astype(jnp.float32) + b.astype(jnp.float32)
    return y.astype(x.dtype)


def rms_norm(x, g):
    xf = x.astype(jnp.float32)
    y = xf * lax.rsqrt(jnp.mean(jnp.square(xf), axis=-1, keepdims=True) + RMS_EPS)
    return (y * g.astype(jnp.float32)).astype(x.dtype)


def rope(x, pos, theta):
    d = x.shape[-1]
    half = d // 2
    inv = theta ** (-jnp.arange(half, dtype=jnp.float32) * (2.0 / d))
    ang = pos.astype(jnp.float32)[:, None] * inv[None, :]
    cos = jnp.cos(ang)[:, None, :]
    sin = jnp.sin(ang)[:, None, :]
    x1 = x[..., :half].astype(jnp.float32)
    x2 = x[..., half:].astype(jnp.float32)
    out = jnp.concatenate([x1 * cos - x2 * sin, x2 * cos + x1 * sin], axis=-1)
    return out.astype(x.dtype)


def window_attention(q, k, v, sink):
    B, S, H, D = q.shape
    KV = k.shape[2]
    G = H // KV
    nb = S // BLOCK
    qb = q.reshape(B, nb, BLOCK, KV, G, D)
    pad = ((0, 0), (BLOCK, BLOCK), (0, 0), (0, 0))
    kp = jnp.pad(k, pad).reshape(B, nb + 2, BLOCK, KV, D)
    vp = jnp.pad(v, pad).reshape(B, nb + 2, BLOCK, KV, D)
    kw = jnp.concatenate([kp[:, :-2], kp[:, 1:-1], kp[:, 2:]], axis=2)
    vw = jnp.concatenate([vp[:, :-2], vp[:, 1:-1], vp[:, 2:]], axis=2)
    s = jnp.einsum('bnqkgd,bnskd->bnkgqs', qb, kw).astype(jnp.float32) / math.sqrt(D)
    blk = jnp.arange(nb, dtype=jnp.int32)[:, None]
    qpos = blk * BLOCK + jnp.arange(BLOCK, dtype=jnp.int32)[None, :]
    kpos = (blk - 1) * BLOCK + jnp.arange(3 * BLOCK, dtype=jnp.int32)[None, :]
    dist = jnp.abs(qpos[:, :, None] - kpos[:, None, :])
    valid = (dist <= WINDOW) & (kpos[:, None, :] >= 0) & (kpos[:, None, :] < S)
    s = jnp.where(valid[None, :, None, None], s, -jnp.inf)
    sink_l = jnp.broadcast_to(sink.astype(jnp.float32).reshape(KV, G)[None, None, :, :, None, None],
                              s.shape[:-1] + (1,))
    p = jax.nn.softmax(jnp.concatenate([s, sink_l], axis=-1), axis=-1)[..., :-1]
    o = jnp.einsum('bnkgqs,bnskd->bnqkgd', p.astype(v.dtype), vw)
    return o.reshape(B, S, H * D)


def dense_block_attention(q, k, v):
    B, S, H, D = q.shape
    KV = k.shape[2]
    G = H // KV
    nb = S // BLOCK
    scale = 1.0 / math.sqrt(D)
    qb = q.reshape(B, nb, BLOCK, KV, G, D).transpose(1, 0, 2, 3, 4, 5)

    def one_block(qblk):
        s = jnp.einsum('bqkgd,bskd->bkgqs', qblk, k).astype(jnp.float32) * scale
        p = jax.nn.softmax(s, axis=-1)
        return jnp.einsum('bkgqs,bskd->bqkgd', p.astype(v.dtype), v)

    o = lax.map(one_block, qb)
    return o.transpose(1, 0, 2, 3, 4, 5).reshape(B, S, H * D)


def spatial_gating(u, v, ln_g, ln_b, w_s, b_s):
    B, S, _ = v.shape
    nc = S // CHUNK
    vc = layer_norm(v, ln_g, ln_b).reshape(B, nc, CHUNK, C_GROUPS, C_GROUP_DIM)
    mixed = jnp.einsum('gij,bnjgc->bnigc', w_s, vc) + b_s.T[None, None, :, :, None]
    return u * mixed.reshape(B, S, C_WIDTH)


def hybrid_mixer(x, pos, row, col, w_in, b_gate, a_sink, b_q_gain, b_k_gain,
                 c_ln_g, c_ln_b, c_ws, c_bs, w_branch, w_mix_out):
    B, S, _ = x.shape
    proj = x @ w_in
    aq, ak, av, bq, bk, bv, cz, gate = jnp.split(proj, _split_points(IN_SIZES), axis=-1)
    aq = rope(aq.reshape(B, S, A_HEADS, HEAD_DIM), pos, ROPE_THETA)
    ak = rope(ak.reshape(B, S, A_KV, HEAD_DIM), pos, ROPE_THETA)
    av = av.reshape(B, S, A_KV, HEAD_DIM)
    out_a = window_attention(aq, ak, av, a_sink)
    half = HEAD_DIM // 2
    bq = rms_norm(bq.reshape(B, S, B_HEADS, HEAD_DIM), b_q_gain)
    bk = rms_norm(bk.reshape(B, S, B_KV, HEAD_DIM), b_k_gain)
    bq = jnp.concatenate([rope(bq[..., :half], row, ROPE_THETA), rope(bq[..., half:], col, ROPE_THETA)], axis=-1)
    bk = jnp.concatenate([rope(bk[..., :half], row, ROPE_THETA), rope(bk[..., half:], col, ROPE_THETA)], axis=-1)
    bv = bv.reshape(B, S, B_KV, HEAD_DIM)
    out_b = dense_block_attention(bq, bk, bv)
    u, v = jnp.split(jax.nn.gelu(cz, approximate=False), 2, axis=-1)
    out_c = spatial_gating(u, v, c_ln_g, c_ln_b, c_ws, c_bs)
    branches = jnp.stack([out_a, out_b, out_c], axis=2)
    gates = jax.nn.sigmoid(gate + b_gate).reshape(B, S, N_BRANCH, D_MODEL)
    merged = (jnp.einsum('bsnc,ncd->bsnd', branches, w_branch) * gates).sum(axis=2)
    return merged @ w_mix_out


def memory_cross_attention(x, mem, wq, wkv, wo):
    B, S, _ = x.shape
    M = mem.shape[1]
    q = (x @ wq).reshape(B, S, X_HEADS, X_HEAD_DIM)
    k, v = jnp.split(mem @ wkv, 2, axis=-1)
    k = k.reshape(B, M, X_HEADS, X_HEAD_DIM)
    v = v.reshape(B, M, X_HEADS, X_HEAD_DIM)
    s = jnp.einsum('bqhd,bmhd->bhqm', q, k).astype(jnp.float32) / math.sqrt(X_HEAD_DIM)
    p = jax.nn.softmax(s, axis=-1)
    o = jnp.einsum('bhqm,bmhd->bqhd', p.astype(v.dtype), v)
    return o.reshape(B, S, X_WIDTH) @ wo


def conv_ffn(x, w_up, conv_k, conv_b, w_down):
    S = x.shape[1]
    h = x @ w_up
    r = CONV_W // 2
    hp = jnp.pad(h, ((0, 0), (r, r), (0, 0)))
    h = sum(hp[:, j:j + S] * conv_k[j] for j in range(CONV_W)) + conv_b
    a, b = jnp.split(h, 2, axis=-1)
    return (jax.nn.gelu(a, approximate=False) * b) @ w_down


def setup_inputs(seed: int = 0) -> dict:
    key = jax.random.key(seed)
    ks = jax.random.split(key, 26)

    def nrm(k, shape, scale):
        return jax.random.normal(k, shape, dtype=jnp.float32) * scale

    L = DEPTH
    return {
        "x": nrm(ks[0], (BATCH, SEQ, D_MODEL), 1.0),
        "mem": nrm(ks[1], (BATCH, MEM_LEN, D_MODEL), 1.0),
        "w_in": nrm(ks[2], (L, D_MODEL, D_IN), D_MODEL ** -0.5),
        "b_gate": nrm(ks[3], (L, N_BRANCH * D_MODEL), 0.1),
        "a_sink": nrm(ks[4], (L, A_HEADS), 1.0),
        "b_q_gain": 1.0 + nrm(ks[5], (L, HEAD_DIM), 0.02),
        "b_k_gain": 1.0 + nrm(ks[6], (L, HEAD_DIM), 0.02),
        "c_ln_g": 1.0 + nrm(ks[7], (L, C_WIDTH), 0.02),
        "c_ln_b": nrm(ks[8], (L, C_WIDTH), 0.02),
        "c_ws": nrm(ks[9], (L, C_GROUPS, CHUNK, CHUNK), CHUNK ** -0.5),
        "c_bs": 1.0 + nrm(ks[10], (L, C_GROUPS, CHUNK), 0.02),
        "w_branch": nrm(ks[11], (L, N_BRANCH, BRANCH_WIDTH, D_MODEL), BRANCH_WIDTH ** -0.5),
        "w_mix_out": nrm(ks[12], (L, D_MODEL, D_MODEL), BETA * D_MODEL ** -0.5),
        "ln1_g": 1.0 + nrm(ks[13], (L, D_MODEL), 0.02),
        "ln1_b": nrm(ks[14], (L, D_MODEL), 0.02),
        "x_wq": nrm(ks[15], (L, D_MODEL, X_WIDTH), D_MODEL ** -0.5),
        "x_wkv": nrm(ks[16], (L, D_MODEL, 2 * X_WIDTH), D_MODEL ** -0.5),
        "x_wo": nrm(ks[17], (L, X_WIDTH, D_MODEL), BETA * X_WIDTH ** -0.5),
        "ln2_g": 1.0 + nrm(ks[18], (L, D_MODEL), 0.02),
        "ln2_b": nrm(ks[19], (L, D_MODEL), 0.02),
        "f_w_up": nrm(ks[20], (L, D_MODEL, 2 * D_FF), D_MODEL ** -0.5),
        "f_conv_k": nrm(ks[21], (L, CONV_W, 2 * D_FF), CONV_W ** -0.5),
        "f_conv_b": nrm(ks[22], (L, 2 * D_FF), 0.02),
        "f_w_down": nrm(ks[23], (L, D_FF, D_MODEL), BETA * D_FF ** -0.5),
        "ln3_g": 1.0 + nrm(ks[24], (L, D_MODEL), 0.02),
        "ln3_b": nrm(ks[25], (L, D_MODEL), 0.02),
    }


def reference(x, mem, w_in, b_gate, a_sink, b_q_gain, b_k_gain, c_ln_g, c_ln_b, c_ws, c_bs,
              w_branch, w_mix_out, ln1_g, ln1_b, x_wq, x_wkv, x_wo, ln2_g, ln2_b,
              f_w_up, f_conv_k, f_conv_b, f_w_down, ln3_g, ln3_b):
    seq = x.shape[1]
    rows = seq // GRID_W
    pos = jnp.arange(seq, dtype=jnp.int32)
    row = jnp.repeat(jnp.arange(rows, dtype=jnp.int32), GRID_W)
    col = jnp.tile(jnp.arange(GRID_W, dtype=jnp.int32), rows)
    for l in range(DEPTH):
        h = hybrid_mixer(x, pos, row, col, w_in[l], b_gate[l], a_sink[l], b_q_gain[l], b_k_gain[l],
                         c_ln_g[l], c_ln_b[l], c_ws[l], c_bs[l], w_branch[l], w_mix_out[l])
        x = layer_norm(ALPHA * x + h, ln1_g[l], ln1_b[l])
        h = memory_cross_attention(x, mem, x_wq[l], x_wkv[l], x_wo[l])
        x = layer_norm(ALPHA * x + h, ln2_g[l], ln2_b[l])
        h = conv_ffn(x, f_w_up[l], f_conv_k[l], f_conv_b[l], f_w_down[l])
        x = layer_norm(ALPHA * x + h, ln3_g[l], ln3_b[l])
    return x
```

```cpp
#include <hip/hip_runtime.h>
#include <hip/hip_cooperative_groups.h>
#include <cstdio>
#include <cstdint>
namespace cg = cooperative_groups;
namespace pg8 {
#define PG8_LAS __attribute__((address_space(3)))
typedef unsigned short bf16_t;
typedef short bf16x8 __attribute__((ext_vector_type(8)));
typedef float f32x4 __attribute__((ext_vector_type(4)));
typedef unsigned u32x4 __attribute__((ext_vector_type(4)));
constexpr int BM = 256, BK = 64, HALF = 128, HTB = HALF * BK * 2  , STAGE_BYTES = 8 * HTB, NXCD = 8, WGM = 8;

__host__ __device__ __forceinline__ int lds_byte(int r, int c) { const int st = (r >> 4) * 2 + (c >> 5), rr = r & 15, cc = c & 31, ob = rr * 64 + cc * 2; return st * 1024 + (ob ^ (((ob >> 9) & 1) << 5)); }
__host__ __device__ __forceinline__ void stage_rc(int b, int& R, int& C) { const int st = b / 1024, sb = b % 1024, swz = sb ^ (((sb >> 9) & 1) << 5); R = (st >> 1) * 16 + swz / 64; C = (st & 1) * 32 + (swz % 64) / 2; }
__host__ __device__ __forceinline__ int perm32(int rho) { const int n = rho >> 4, i = rho & 15; return 8 * (i >> 2) + 4 * n + (i & 3); }

struct Unit { int pm, pn; };
struct Gemm { const bf16_t* A; const bf16_t* Bt; int M, N, K; };

struct StaticOrder {
    int nM, nN, nwg, G, c;
    __host__ __device__ void init(int M, int N, int G_, int c_) { nM = M / BM; nN = N / BM; nwg = nM * nN; G = G_; c = c_; }
    __host__ __device__ bool next(int i, Unit& u) const {
        const long L = (long)i * G + c; if (L >= nwg) return false;
        int wgid = (int)L; { const int q = nwg / NXCD, r = nwg % NXCD, xcd = wgid % NXCD, off = wgid / NXCD; wgid = (xcd < r ? xcd * (q + 1) : r * (q + 1) + (xcd - r) * q) + off; }
        const int nig = WGM * nN, gid = wgid / nig, fm = gid * WGM, gsz = (nM - fm) < WGM ? (nM - fm) : WGM;
        u.pm = fm + ((wgid % nig) % gsz); u.pn = (wgid % nig) / gsz; return true;
    }
    __device__ __forceinline__ void a_ready(const Unit&) const {}
    __device__ __forceinline__ void done(const Unit&) const {}
};

__device__ __forceinline__ unsigned cvt_pk_bf16(float lo, float hi) { unsigned r; asm volatile("v_cvt_pk_bf16_f32 %0, %1, %2" : "=v"(r) : "v"(lo), "v"(hi)); return r; }
typedef float f32x2 __attribute__((ext_vector_type(2)));
__device__ __forceinline__ f32x2 gelu_pk(f32x2 v) {
    const f32x2 av = __builtin_elementwise_abs(v), d = av * 0.2316418882f + 1.0f;
    f32x2 t; t.x = __builtin_amdgcn_rcpf(d.x); t.y = __builtin_amdgcn_rcpf(d.y);
    f32x2 q = t * 0.5307027145f + (-0.7265760135f); q = q * t + 0.7107068705f; q = q * t + (-0.142248368f); q = q * t + 0.127414796f; q = q * t;
    const f32x2 s = (v * v) * (-0.72134752044f);
    f32x2 e; e.x = __builtin_amdgcn_exp2f(s.x); e.y = __builtin_amdgcn_exp2f(s.y);
    const f32x2 m = v * (q * e), r = v - m;
    f32x2 o; o.x = v.x < 0.f ? m.x : r.x; o.y = v.y < 0.f ? m.y : r.y; return o;
}
__device__ __forceinline__ unsigned f2bf(float f) { unsigned u = __builtin_bit_cast(unsigned, f); return (u + 0x7fffu + ((u >> 16) & 1u)) >> 16; }
__device__ __forceinline__ unsigned pk2(float lo, float hi) { return f2bf(lo) | (f2bf(hi) << 16); }
__device__ __forceinline__ u32x4 pack8(f32x4 a, f32x4 b) { u32x4 w; w.x = pk2(a[0], a[1]); w.y = pk2(a[2], a[3]); w.z = pk2(b[0], b[1]); w.w = pk2(b[2], b[3]); return w; }
__device__ __forceinline__ float bflo(unsigned w) { return __builtin_bit_cast(float, w << 16); }
__device__ __forceinline__ float bfhi(unsigned w) { return __builtin_bit_cast(float, w & 0xffff0000u); }
template <class F> struct EpiRow8 {
    static constexpr bool PERM = true, AFTER_DRAIN = false;
    F f;
    __device__ __forceinline__ void operator()(const f32x4 (&acc)[2][2][4][2], const Unit& u, int wr, int wc, int fr, int fq) const {
#pragma unroll
        for (int ai = 0; ai < 2; ++ai)
#pragma unroll
            for (int m = 0; m < 4; ++m) {
                const int row = u.pm * BM + ai * HALF + wr * 64 + m * 16 + fr;
#pragma unroll
                for (int bj = 0; bj < 2; ++bj) {
                    const int col = u.pn * BM + bj * HALF + wc * 32 + 8 * fq;
                    f(row, col, acc[ai][bj][m][0], acc[ai][bj][m][1]);
                }
                asm volatile("" ::: "memory");
            }
    }
};
struct FStoreBf16 { bf16_t* O; int ldc; float scale;
    __device__ __forceinline__ void operator()(int row, int col, f32x4 v0, f32x4 v1) const {
        *(u32x4*)(O + (size_t)row * ldc + col) = pack8(v0 * scale, v1 * scale); } };
struct FBranch { bf16_t* Mg; const bf16_t* G; int ldg; int first;
    __device__ __forceinline__ void operator()(int row, int col, f32x4 v0, f32x4 v1) const {
        const u32x4 g = *(const u32x4*)(G + (size_t)row * ldg + col);
        f32x4 g0 = {bflo(g.x), bfhi(g.x), bflo(g.y), bfhi(g.y)}, g1 = {bflo(g.z), bfhi(g.z), bflo(g.w), bfhi(g.w)};
        v0 = v0 * g0; v1 = v1 * g1;
        bf16_t* mp = Mg + (size_t)row * 1024 + col;
        if (!first) { const u32x4 o = *(const u32x4*)mp; v0 += (f32x4){bflo(o.x), bfhi(o.x), bflo(o.y), bfhi(o.y)}; v1 += (f32x4){bflo(o.z), bfhi(o.z), bflo(o.w), bfhi(o.w)}; }
        *(u32x4*)mp = pack8(v0, v1); } };
struct FResid { const float* X; float* Y; float alpha;
    __device__ __forceinline__ void operator()(int row, int col, f32x4 v0, f32x4 v1) const {
        const size_t o = (size_t)row * 1024 + col;
        const f32x4 x0 = *(const f32x4*)(X + o), x1 = *(const f32x4*)(X + o + 4);
        *(f32x4*)(Y + o) = x0 * alpha + v0; *(f32x4*)(Y + o + 4) = x1 * alpha + v1; } };
template <class Epi, class Sched, bool ALIGN_EPI = false, bool SP2 = false>
__device__ __forceinline__ void gemm_phase(PG8_LAS unsigned char* lds, const Gemm g, const Sched& S, const Epi& E) {
    int tid_l = threadIdx.x; asm volatile("" : "+v"(tid_l));
    const int tid = tid_l, wid = __builtin_amdgcn_readfirstlane(tid >> 6), lane = tid & 63, wr = wid >> 2, wc = wid & 3, fr = lane & 15, fq = lane >> 4;
    const int K = g.K, nt = K / BK;
    unsigned voffA[2], voffB[2];
#pragma unroll
    for (int i = 0; i < 2; ++i) { int R, C; stage_rc(tid * 16 + i * 8192, R, C); const int Rb = Epi::PERM ? ((R & ~31) + perm32(R & 31)) : R;
        voffA[i] = (unsigned)(R * K + C) * 2u; voffB[i] = (unsigned)(Rb * K + C) * 2u; }
    const size_t kstep = (size_t)(BK * 2);
    const size_t hstep = (size_t)HALF * K * 2;
    const size_t tstep = 2 * hstep;
    const unsigned ldsw = (unsigned)wid * 1024u;
    const int aoff = lds_byte(wr * 64 + fr, fq * 8), boff = lds_byte(wc * 32 + fr, fq * 8);
#define PG8_SA(b, h) (((b) * 2 + (h)) * HTB)
#define PG8_SB(b, h) ((4 + (b) * 2 + (h)) * HTB)
#define PG8_STAGE(bufoff, gbase, voff) do { _Pragma("unroll") for (int _i = 0; _i < 2; ++_i) \
        __builtin_amdgcn_global_load_lds((const unsigned*)((const char*)(gbase) + (voff)[_i]), (PG8_LAS unsigned*)(lds + (bufoff) + ldsw + _i * 8192), 16, 0, 0); } while (0)
#define PG8_LDA(dst, b, h) do { _Pragma("unroll") for (int m = 0; m < 4; ++m) _Pragma("unroll") for (int k = 0; k < 2; ++k) dst[m][k] = *(const PG8_LAS bf16x8*)(lds + PG8_SA(b, h) + aoff + m * 2048 + k * 1024); } while (0)
#define PG8_LDB(dst, b, h) do { _Pragma("unroll") for (int n = 0; n < 2; ++n) _Pragma("unroll") for (int k = 0; k < 2; ++k) dst[n][k] = *(const PG8_LAS bf16x8*)(lds + PG8_SB(b, h) + boff + n * 2048 + k * 1024); } while (0)
#define PG8_MMA(ai, bj, At, Bt) do { __builtin_amdgcn_s_setprio(1); _Pragma("unroll") for (int m = 0; m < 4; ++m) _Pragma("unroll") for (int n = 0; n < 2; ++n) _Pragma("unroll") for (int k = 0; k < 2; ++k) \
        acc[ai][bj][m][n] = __builtin_amdgcn_mfma_f32_16x16x32_bf16(Bt[n][k], At[m][k], acc[ai][bj][m][n], 0, 0, 0); __builtin_amdgcn_s_setprio(0); } while (0)
#define PG8_WAIT_V(n) asm volatile("s_waitcnt vmcnt(" #n ")" ::: "memory")
#define PG8_WAIT_L(n) asm volatile("s_waitcnt lgkmcnt(" #n ")" ::: "memory")
#define PG8_BAR __builtin_amdgcn_s_barrier()
#define PG8_SCHED __builtin_amdgcn_sched_barrier(0)
    Unit cur, nxt; int ui = 0;
    if (!S.next(0, cur)) return;
    f32x4 acc[2][2][4][2];
#pragma unroll
    for (int a = 0; a < 2; ++a)
#pragma unroll
        for (int b = 0; b < 2; ++b)
#pragma unroll
            for (int m = 0; m < 4; ++m)
#pragma unroll
                for (int n = 0; n < 2; ++n) acc[a][b][m][n] = (f32x4){0.f, 0.f, 0.f, 0.f};
    bf16x8 At[4][2], B0[2][2], B1[2][2];
    const char* cA = (const char*)g.A + (size_t)cur.pm * tstep; const char* cB = (const char*)g.Bt + (size_t)cur.pn * tstep;
    S.a_ready(cur);
    if constexpr (SP2) {
        PG8_STAGE(PG8_SB(0, 0), cB, voffB); PG8_STAGE(PG8_SB(0, 1), cB + hstep, voffB); PG8_STAGE(PG8_SA(0, 0), cA, voffA); PG8_STAGE(PG8_SA(0, 1), cA + hstep, voffA);
        if (wr == 1) PG8_BAR;
        PG8_WAIT_V(2); PG8_BAR;
        PG8_STAGE(PG8_SB(1, 0), cB + kstep, voffB); PG8_STAGE(PG8_SA(1, 0), cA + kstep, voffA); PG8_STAGE(PG8_SB(1, 1), cB + hstep + kstep, voffB);
        PG8_WAIT_V(6); PG8_BAR;
    } else {
        PG8_STAGE(PG8_SB(0, 0), cB, voffB); PG8_STAGE(PG8_SA(0, 0), cA, voffA); PG8_STAGE(PG8_SB(0, 1), cB + hstep, voffB); PG8_STAGE(PG8_SA(0, 1), cA + hstep, voffA);
        if (wr == 1) PG8_BAR;
        PG8_WAIT_V(4); PG8_BAR;
        PG8_STAGE(PG8_SB(1, 0), cB + kstep, voffB); PG8_STAGE(PG8_SA(1, 0), cA + kstep, voffA); PG8_STAGE(PG8_SB(1, 1), cB + hstep + kstep, voffB);
        PG8_WAIT_V(6); PG8_BAR;
    }
    for (;;) {
        const bool has_next = S.next(ui + 1, nxt);
        const char* nA = has_next ? (const char*)g.A + (size_t)nxt.pm * tstep : cA; const char* nB = has_next ? (const char*)g.Bt + (size_t)nxt.pn * tstep : cB;
        for (int t = 0; t < nt; t += 2) {
            const bool last = (t == nt - 2);
            const char* a1 = cA + (size_t)(t + 1) * kstep;
            const char* a2 = last ? nA : cA + (size_t)(t + 2) * kstep; const char* b2 = last ? nB : cB + (size_t)(t + 2) * kstep;
            const char* a3 = a2 + kstep; const char* b3 = b2 + kstep;
            if (last && has_next) S.a_ready(nxt);
            if constexpr (SP2) {
            PG8_LDB(B0, 0, 0); PG8_LDB(B1, 0, 1); PG8_SCHED; PG8_LDA(At, 0, 0); PG8_STAGE(PG8_SA(1, 1), a1 + hstep, voffA);
            PG8_WAIT_V(8); PG8_WAIT_L(0); PG8_BAR; PG8_MMA(0, 0, At, B0); PG8_MMA(0, 1, At, B1); PG8_BAR; PG8_SCHED;
            PG8_LDA(At, 0, 1); PG8_STAGE(PG8_SB(0, 0), b2, voffB); PG8_STAGE(PG8_SB(0, 1), b2 + hstep, voffB); PG8_STAGE(PG8_SA(0, 0), a2, voffA);
            PG8_WAIT_V(8); PG8_WAIT_L(0); PG8_BAR; PG8_MMA(1, 0, At, B0); PG8_MMA(1, 1, At, B1); PG8_BAR; PG8_SCHED;
            PG8_LDB(B0, 1, 0); PG8_LDB(B1, 1, 1); PG8_SCHED; PG8_LDA(At, 1, 0); PG8_STAGE(PG8_SA(0, 1), a2 + hstep, voffA);
            PG8_WAIT_V(8); PG8_WAIT_L(0); PG8_BAR; PG8_MMA(0, 0, At, B0); PG8_MMA(0, 1, At, B1); PG8_BAR; PG8_SCHED;
            PG8_LDA(At, 1, 1); PG8_STAGE(PG8_SB(1, 0), b3, voffB); PG8_STAGE(PG8_SB(1, 1), b3 + hstep, voffB); PG8_STAGE(PG8_SA(1, 0), a3, voffA);
            PG8_WAIT_V(8); PG8_WAIT_L(0); PG8_BAR; PG8_MMA(1, 0, At, B0); PG8_MMA(1, 1, At, B1); PG8_BAR; PG8_SCHED;
            } else {
            PG8_LDB(B0, 0, 0); PG8_SCHED; PG8_LDA(At, 0, 0); PG8_STAGE(PG8_SA(1, 1), a1 + hstep, voffA);
            PG8_WAIT_L(8); PG8_BAR; PG8_WAIT_L(0); PG8_MMA(0, 0, At, B0); PG8_BAR; PG8_SCHED;
            PG8_LDB(B1, 0, 1); PG8_STAGE(PG8_SB(0, 0), b2, voffB);
            PG8_BAR; PG8_WAIT_L(0); PG8_MMA(0, 1, At, B1); PG8_BAR;
            PG8_LDA(At, 0, 1); PG8_STAGE(PG8_SA(0, 0), a2, voffA);
            PG8_BAR; PG8_WAIT_L(0); PG8_MMA(1, 0, At, B0); PG8_BAR; PG8_SCHED;
            PG8_STAGE(PG8_SB(0, 1), b2 + hstep, voffB);
            PG8_WAIT_V(6); PG8_BAR; PG8_MMA(1, 1, At, B1); PG8_BAR;
            PG8_LDB(B0, 1, 0); PG8_SCHED; PG8_LDA(At, 1, 0); PG8_STAGE(PG8_SA(0, 1), a2 + hstep, voffA);
            PG8_WAIT_L(8); PG8_BAR; PG8_WAIT_L(0); PG8_MMA(0, 0, At, B0); PG8_BAR; PG8_SCHED;
            PG8_LDB(B1, 1, 1); PG8_STAGE(PG8_SB(1, 0), b3, voffB);
            PG8_BAR; PG8_WAIT_L(0); PG8_MMA(0, 1, At, B1); PG8_BAR;
            PG8_LDA(At, 1, 1); PG8_STAGE(PG8_SA(1, 0), a3, voffA);
            PG8_BAR; PG8_WAIT_L(0); PG8_MMA(1, 0, At, B0); PG8_BAR; PG8_SCHED;
            PG8_STAGE(PG8_SB(1, 1), b3 + hstep, voffB);
            PG8_WAIT_V(6); PG8_BAR; PG8_MMA(1, 1, At, B1); PG8_BAR;
            }
        }
        if constexpr (ALIGN_EPI) { if (wr == 0) PG8_BAR; }
        if constexpr (!Epi::AFTER_DRAIN) { E(acc, cur, wr, wc, fr, fq); S.done(cur); }
        if (!has_next) break;
#pragma unroll
        for (int a = 0; a < 2; ++a)
#pragma unroll
            for (int b = 0; b < 2; ++b)
#pragma unroll
                for (int m = 0; m < 4; ++m)
#pragma unroll
                    for (int n = 0; n < 2; ++n) acc[a][b][m][n] = (f32x4){0.f, 0.f, 0.f, 0.f};
        cur = nxt; cA = nA; cB = nB; ++ui;
        if constexpr (ALIGN_EPI) { if (wr == 1) PG8_BAR; }
    }
    PG8_WAIT_V(0);
    if constexpr (!ALIGN_EPI) { if (wr == 0) PG8_BAR; }
    PG8_BAR;
    if constexpr (Epi::AFTER_DRAIN) { E.fused(acc, cur, wr, wc, fr, fq, lds, wid, lane); S.done(cur); }
#undef PG8_SA
#undef PG8_SB
#undef PG8_STAGE
#undef PG8_LDA
#undef PG8_LDB
#undef PG8_MMA
#undef PG8_WAIT_V
#undef PG8_WAIT_L
#undef PG8_BAR
#undef PG8_SCHED
}
}
using pg8::bf16_t; using pg8::f32x4; using pg8::u32x4;
#define LAS __attribute__((address_space(3)))
constexpr int NB = 4, S = 4096, T = NB * S, D = 1024, DIN = 5632, DEPTH = 4, DFF = 2816, MEM = 256;
constexpr int C_AQ = 0, C_AK = 512, C_AV = 640, C_BQ = 768, C_BK = 1280, C_BV = 1408, C_U = 1536, C_V = 2048, C_G = 2560;
constexpr float ALPHA = 1.681792830507429f;
constexpr float LN_EPS = 1e-5f, RMS_EPS = 1e-6f;
constexpr size_t MiB = 1u << 20;
constexpr size_t WS_COSA = 0, WS_SINA = 512 * 1024, WS_TABB = 1 * MiB;
constexpr size_t WS_W = 2 * MiB;
constexpr size_t W_IN = 0, W_BR = W_IN + (size_t)DIN * D * 2, W_MIX = W_BR + 3u * D * 512 * 2, W_Q = W_MIX + (size_t)D * D * 2, W_KV = W_Q + 512u * D * 2,
                 W_O = W_KV + (size_t)D * D * 2, W_UP = W_O + (size_t)D * 512 * 2, W_DN = W_UP + (size_t)DIN * D * 2, W_END = W_DN + (size_t)D * DFF * 2;
static_assert(W_END <= 38 * MiB, "weights");
constexpr size_t WS_MEMB = 40 * MiB, WS_MEMKV = 42 * MiB, WS_XB = 44 * MiB, WS_R1 = 76 * MiB, WS_R2 = 252 * MiB, WS_END = 348 * MiB;
constexpr size_t R2_BR = 0, R2_MERGED = 48 * MiB, R2_XQ = 80 * MiB, R2_XO = 0, R2_G = 0;
constexpr int LDS_BYTES = 147456;

struct Args { const float* in[26]; float* out; unsigned char* ws; };

__device__ __forceinline__ float bf2f(bf16_t b) { return __builtin_bit_cast(float, (unsigned)b << 16); }
__device__ __forceinline__ bf16_t f2b(float f) { return (bf16_t)pg8::f2bf(f); }
__device__ __forceinline__ float wave_sum(float v) {
#pragma unroll
    for (int o = 1; o < 64; o <<= 1) v += __shfl_xor(v, o);
    return v;
}
__device__ __forceinline__ float gelu_exact(float x) { return 0.5f * x * (1.0f + erff(x * 0.70710678118654752f)); }

__device__ __forceinline__ void transpose_item(const float* W, int K, int N, bf16_t* WT, LAS float* scr, int item, int lane) {
    const int nblk = N / 32, kb = item / nblk, nb = item % nblk, k0 = 64 * kb, n0 = 32 * nb;
#pragma unroll 8
    for (int i = 0; i < 32; ++i) { const int kk = 2 * i + (lane >> 5); scr[kk * 33 + (lane & 31)] = W[(size_t)(k0 + kk) * N + n0 + (lane & 31)]; }
    asm volatile("s_waitcnt lgkmcnt(0)" ::: "memory");
    const int c = lane & 7;
#pragma unroll
    for (int j = 0; j < 4; ++j) { const int n = (lane >> 3) + 8 * j; const LAS float* s = scr + (8 * c) * 33 + n;
        u32x4 o; o.x = pg8::pk2(s[0 * 33], s[1 * 33]); o.y = pg8::pk2(s[2 * 33], s[3 * 33]); o.z = pg8::pk2(s[4 * 33], s[5 * 33]); o.w = pg8::pk2(s[6 * 33], s[7 * 33]);
        *(u32x4*)(WT + (size_t)(n0 + n) * K + k0 + 8 * c) = o; }
    asm volatile("s_waitcnt lgkmcnt(0)" ::: "memory");
}
__device__ __forceinline__ void transpose_mat(const float* W, int K, int N, bf16_t* WT, LAS float* scr, int gw, int GW, int lane) {
    const int nit = (K / 64) * (N / 32);
    for (int it = gw; it < nit; it += GW) transpose_item(W, K, N, WT, scr, it, lane);
}

__device__ __forceinline__ void ln_phase(const float* y, const float* g, const float* b, float* xo, bf16_t* xb, int gw, int GW, int lane) {
    for (int r = gw; r < T; r += GW) {
        const f32x4* yr = (const f32x4*)(y + (size_t)r * D) + lane;
        f32x4 v[4]; float s = 0.f;
#pragma unroll
        for (int j = 0; j < 4; ++j) { v[j] = yr[64 * j]; s += (v[j].x + v[j].y) + (v[j].z + v[j].w); }
        const float mean = wave_sum(s) * (1.f / D); float s2 = 0.f;
#pragma unroll
        for (int j = 0; j < 4; ++j) { v[j] = v[j] - mean; s2 += (v[j].x * v[j].x + v[j].y * v[j].y) + (v[j].z * v[j].z + v[j].w * v[j].w); }
        const float rstd = 1.f / sqrtf(wave_sum(s2) * (1.f / D) + LN_EPS);
#pragma unroll
        for (int j = 0; j < 4; ++j) { const int col = 4 * lane + 256 * j; const f32x4 gg = *(const f32x4*)(g + col), bb = *(const f32x4*)(b + col);
            const f32x4 o = v[j] * rstd * gg + bb;
            *(f32x4*)(xo + (size_t)r * D + col) = o;
            *(unsigned long long*)(xb + (size_t)r * D + col) = (unsigned long long)pg8::pk2(o.x, o.y) | ((unsigned long long)pg8::pk2(o.z, o.w) << 32); }
    }
}

__device__ __forceinline__ void prep_phase(bf16_t* proj, const float* bgate, const float* qgain, const float* kgain, const float* lng, const float* lnb,
                                           const float* cosA, const float* sinA, const float* tabB, int gt, int GT) {
    const int lane = gt & 63, gw = gt >> 6, GW = GT >> 6;
    for (int unit = gt; unit < T * 20; unit += GT) {
        const int t = unit / 20, hh = unit % 20, s = t % S;
        bf16_t* row = proj + (size_t)t * DIN;
        if (hh < 10) {
            bf16_t* p = row + hh * 64; const float* c = cosA + s * 32; const float* sn = sinA + s * 32;
            for (int i = 0; i < 32; ++i) { const float x1 = bf2f(p[i]), x2 = bf2f(p[i + 32]); p[i] = f2b(x1 * c[i] - x2 * sn[i]); p[i + 32] = f2b(x2 * c[i] + x1 * sn[i]); }
        } else {
            const int hb = hh - 10; bf16_t* p = row + C_BQ + hb * 64; const float* gain = hb < 8 ? qgain : kgain;
            float ss = 0.f; for (int i = 0; i < 64; ++i) { const float x = bf2f(p[i]); ss += x * x; }
            const float rstd = 1.0f / sqrtf(ss * (1.f / 64.f) + RMS_EPS);
            const int r = s / 64, cc = s % 64;
            for (int i = 0; i < 16; ++i) { const float x1 = bf2f(p[i]) * rstd * gain[i], x2 = bf2f(p[i + 16]) * rstd * gain[i + 16]; const float c = tabB[r * 16 + i], sn = tabB[1024 + r * 16 + i];
                p[i] = f2b(x1 * c - x2 * sn); p[i + 16] = f2b(x2 * c + x1 * sn); }
            for (int i = 0; i < 16; ++i) { const float x1 = bf2f(p[32 + i]) * rstd * gain[32 + i], x2 = bf2f(p[48 + i]) * rstd * gain[48 + i]; const float c = tabB[cc * 16 + i], sn = tabB[1024 + cc * 16 + i];
                p[32 + i] = f2b(x1 * c - x2 * sn); p[48 + i] = f2b(x2 * c + x1 * sn); }
        }
    }
    for (int unit = gt; unit < T * 448; unit += GT) {
        const int t = unit / 448, ch = unit % 448;
        const int col = ch < 64 ? C_U + ch * 8 : C_G + (ch - 64) * 8;
        u32x4* p = (u32x4*)(proj + (size_t)t * DIN + col); const u32x4 w = *p;
        float v[8] = {pg8::bflo(w.x), pg8::bfhi(w.x), pg8::bflo(w.y), pg8::bfhi(w.y), pg8::bflo(w.z), pg8::bfhi(w.z), pg8::bflo(w.w), pg8::bfhi(w.w)};
        if (ch < 64) {
#pragma unroll
            for (int e = 0; e < 8; ++e) v[e] = gelu_exact(v[e]);
        } else {
#pragma unroll
            for (int e = 0; e < 8; ++e) v[e] = 1.0f / (1.0f + __expf(-(v[e] + bgate[col - C_G + e])));
        }
        u32x4 o; o.x = pg8::pk2(v[0], v[1]); o.y = pg8::pk2(v[2], v[3]); o.z = pg8::pk2(v[4], v[5]); o.w = pg8::pk2(v[6], v[7]); *p = o;
    }
    for (int t = gw; t < T; t += GW) {
        u32x4* p = (u32x4*)(proj + (size_t)t * DIN + C_V + lane * 8); const u32x4 w = *p;
        float v[8] = {pg8::bflo(w.x), pg8::bfhi(w.x), pg8::bflo(w.y), pg8::bfhi(w.y), pg8::bflo(w.z), pg8::bfhi(w.z), pg8::bflo(w.w), pg8::bfhi(w.w)};
        float s = 0.f;
#pragma unroll
        for (int e = 0; e < 8; ++e) { v[e] = gelu_exact(v[e]); s += v[e]; }
        const float mean = wave_sum(s) * (1.f / 512.f); float s2 = 0.f;
#pragma unroll
        for (int e = 0; e < 8; ++e) { v[e] -= mean; s2 += v[e] * v[e]; }
        const float rstd = 1.0f / sqrtf(wave_sum(s2) * (1.f / 512.f) + LN_EPS);
#pragma unroll
        for (int e = 0; e < 8; ++e) v[e] = v[e] * rstd * lng[lane * 8 + e] + lnb[lane * 8 + e];
        u32x4 o; o.x = pg8::pk2(v[0], v[1]); o.y = pg8::pk2(v[2], v[3]); o.z = pg8::pk2(v[4], v[5]); o.w = pg8::pk2(v[6], v[7]); *p = o;
    }
}

template <int NP, bool WINDOW>
__device__ __forceinline__ void naive_attn(const bf16_t* Q, int qp, const bf16_t* Kp, int kp, const bf16_t* Vp, int vp, bf16_t* O, int op,
                                           int H, int hshift, int Sq, int Skv, float scale, const float* sink, int gt, int GT) {
    constexpr int HD = 64 * NP;
    for (int unit = gt; unit < H * T * NP; unit += GT) {
        const int part = unit % NP, t = (unit / NP) % T, h = unit / (NP * T), b = t / Sq, s = t % Sq, kvh = h >> hshift;
        float q[64], o[64];
        { const u32x4* qv = (const u32x4*)(Q + (size_t)t * qp + h * HD + part * 64);
#pragma unroll
          for (int c = 0; c < 8; ++c) { const u32x4 w = qv[c]; q[c * 8 + 0] = pg8::bflo(w.x) * scale; q[c * 8 + 1] = pg8::bfhi(w.x) * scale; q[c * 8 + 2] = pg8::bflo(w.y) * scale; q[c * 8 + 3] = pg8::bfhi(w.y) * scale;
              q[c * 8 + 4] = pg8::bflo(w.z) * scale; q[c * 8 + 5] = pg8::bfhi(w.z) * scale; q[c * 8 + 6] = pg8::bflo(w.w) * scale; q[c * 8 + 7] = pg8::bfhi(w.w) * scale; } }
#pragma unroll
        for (int d = 0; d < 64; ++d) o[d] = 0.f;
        float m = WINDOW ? sink[h] : -1e30f, l = WINDOW ? 1.f : 0.f;
        const int s0 = s & ~63;
        const int jlo = WINDOW ? (s0 - 128 > 0 ? s0 - 128 : 0) : 0, jhi = WINDOW ? (s0 + 191 < Skv - 1 ? s0 + 191 : Skv - 1) : Skv - 1;
        for (int j = jlo; j <= jhi; ++j) {
            const u32x4* kv = (const u32x4*)(Kp + (size_t)(b * Skv + j) * kp + kvh * HD + part * 64);
            float sc = 0.f;
#pragma unroll
            for (int c = 0; c < 8; ++c) { const u32x4 w = kv[c];
                sc += q[c * 8 + 0] * pg8::bflo(w.x) + q[c * 8 + 1] * pg8::bfhi(w.x) + q[c * 8 + 2] * pg8::bflo(w.y) + q[c * 8 + 3] * pg8::bfhi(w.y)
                    + q[c * 8 + 4] * pg8::bflo(w.z) + q[c * 8 + 5] * pg8::bfhi(w.z) + q[c * 8 + 6] * pg8::bflo(w.w) + q[c * 8 + 7] * pg8::bfhi(w.w); }
            if (NP == 2) sc += __shfl_xor(sc, 1);
            const int dj = s - j; const bool valid = !WINDOW || (dj <= 128 && dj >= -128);
            if (valid) {
                const float mn = fmaxf(m, sc), f = __expf(m - mn), p = __expf(sc - mn);
                l = l * f + p; m = mn;
                const u32x4* vv = (const u32x4*)(Vp + (size_t)(b * Skv + j) * vp + kvh * HD + part * 64);
#pragma unroll
                for (int c = 0; c < 8; ++c) { const u32x4 w = vv[c];
                    o[c * 8 + 0] = o[c * 8 + 0] * f + p * pg8::bflo(w.x); o[c * 8 + 1] = o[c * 8 + 1] * f + p * pg8::bfhi(w.x); o[c * 8 + 2] = o[c * 8 + 2] * f + p * pg8::bflo(w.y); o[c * 8 + 3] = o[c * 8 + 3] * f + p * pg8::bfhi(w.y);
                    o[c * 8 + 4] = o[c * 8 + 4] * f + p * pg8::bflo(w.z); o[c * 8 + 5] = o[c * 8 + 5] * f + p * pg8::bfhi(w.z); o[c * 8 + 6] = o[c * 8 + 6] * f + p * pg8::bflo(w.w); o[c * 8 + 7] = o[c * 8 + 7] * f + p * pg8::bfhi(w.w); }
            }
        }
        const float il = 1.0f / l;
        u32x4* ov = (u32x4*)(O + (size_t)t * op + h * HD + part * 64);
#pragma unroll
        for (int c = 0; c < 8; ++c) { u32x4 w; w.x = pg8::pk2(o[c * 8 + 0] * il, o[c * 8 + 1] * il); w.y = pg8::pk2(o[c * 8 + 2] * il, o[c * 8 + 3] * il); w.z = pg8::pk2(o[c * 8 + 4] * il, o[c * 8 + 5] * il); w.w = pg8::pk2(o[c * 8 + 6] * il, o[c * 8 + 7] * il); ov[c] = w; }
    }
}

__device__ __forceinline__ void naive_gmlp(const bf16_t* proj, const float* ws, const float* bs, bf16_t* out, int gt, int GT) {
    for (int unit = gt; unit < T * 512; unit += GT) {
        const int t = unit / 512, ch = unit % 512, g = ch / 128, i = t % 128, tb = t - i;
        const float* w = ws + ((size_t)g * 128 + i) * 128;
        float acc = 0.f;
        for (int j = 0; j < 128; ++j) acc += w[j] * bf2f(proj[(size_t)(tb + j) * DIN + C_V + ch]);
        acc += bs[g * 128 + i];
        out[(size_t)t * 512 + ch] = f2b(bf2f(proj[(size_t)t * DIN + C_U + ch]) * acc);
    }
}

__device__ __forceinline__ void naive_conv(const bf16_t* hup, const float* ck, const float* cb, bf16_t* g, int gt, int GT) {
    for (int unit = gt; unit < T * DFF; unit += GT) {
        const int t = unit / DFF, c = unit % DFF, s = t % S;
        const bf16_t* h0 = hup + (size_t)t * DIN;
        float a = ck[DIN + c] * bf2f(h0[c]) + cb[c], b = ck[DIN + DFF + c] * bf2f(h0[DFF + c]) + cb[DFF + c];
        if (s > 0) { a += ck[c] * bf2f(h0[c - DIN]); b += ck[DFF + c] * bf2f(h0[DFF + c - DIN]); }
        if (s < S - 1) { a += ck[2 * DIN + c] * bf2f(h0[c + DIN]); b += ck[2 * DIN + DFF + c] * bf2f(h0[DFF + c + DIN]); }
        g[(size_t)t * DFF + c] = f2b(gelu_exact(a) * b);
    }
}

template <class F> __device__ __forceinline__ void run_gemm(LAS unsigned char* lds, const bf16_t* A, const bf16_t* Bt, int M, int N, int K, const F& f) {
    pg8::Gemm g{A, Bt, M, N, K}; pg8::StaticOrder So; So.init(M, N, (int)gridDim.x, (int)blockIdx.x);
    pg8::EpiRow8<F> E{f};
    pg8::gemm_phase<pg8::EpiRow8<F>, pg8::StaticOrder, true, true>(lds, g, So, E);
}

typedef const __attribute__((address_space(4))) unsigned char* kargp_t;
__device__ __forceinline__ const float* karg_in(int i) { kargp_t kp = (kargp_t)__builtin_amdgcn_kernarg_segment_ptr(); return (const float*)*(const unsigned long long volatile __attribute__((address_space(4)))*)(kp + 8 * i); }
#define INP(i) karg_in(i)
#define XOUT ((float*)karg_in(26))
#define WSB ((unsigned char*)karg_in(27))
#define TIDS() int tid_ = threadIdx.x; asm volatile("" : "+v"(tid_)); const int tid = tid_, lane = tid & 63, wave = __builtin_amdgcn_readfirstlane(tid >> 6); \
    const int gt = blockIdx.x * 512 + tid, GT = gridDim.x * 512, gw = gt >> 6, GW = GT >> 6; (void)lane; (void)wave; (void)gt; (void)GT; (void)gw; (void)GW
#define WP(off) ((bf16_t*)(WSB + WS_W + (off)))

__global__ void __launch_bounds__(512, 2) fwd_kernel(Args a) {
    extern __shared__ __attribute__((aligned(16))) unsigned char lds_raw[];
    cg::grid_group grid = cg::this_grid();
    LAS unsigned char* lds = (LAS unsigned char*)lds_raw;

    { TIDS();
      const float* xin = INP(0); float* X = XOUT; unsigned char* ws = WSB; bf16_t* xb = (bf16_t*)(ws + WS_XB); bf16_t* memb = (bf16_t*)(ws + WS_MEMB);
      float* cosA = (float*)(ws + WS_COSA); float* sinA = (float*)(ws + WS_SINA); float* tabB = (float*)(ws + WS_TABB);
      for (int i = gt; i < T * D / 4; i += GT) { const f32x4 v = ((const f32x4*)xin)[i]; ((f32x4*)X)[i] = v;
          ((unsigned long long*)xb)[i] = (unsigned long long)pg8::pk2(v.x, v.y) | ((unsigned long long)pg8::pk2(v.z, v.w) << 32); }
      const float* mem = INP(1);
      for (int i = gt; i < NB * MEM * D / 4; i += GT) { const f32x4 v = ((const f32x4*)mem)[i];
          ((unsigned long long*)memb)[i] = (unsigned long long)pg8::pk2(v.x, v.y) | ((unsigned long long)pg8::pk2(v.z, v.w) << 32); }
      for (int i = gt; i < S * 32; i += GT) { const int s = i >> 5, k = i & 31; const float inv = powf(10000.0f, -(float)k * (1.0f / 32.0f)); const float ang = (float)s * inv; cosA[i] = cosf(ang); sinA[i] = sinf(ang); }
      for (int i = gt; i < 64 * 16; i += GT) { const int p = i >> 4, k = i & 15; const float inv = powf(10000.0f, -(float)k * (1.0f / 16.0f)); const float ang = (float)p * inv; tabB[i] = cosf(ang); tabB[1024 + i] = sinf(ang); }
    }

    for (int l = 0; l < DEPTH; ++l) {
        asm volatile("" : "+s"(l));
        { TIDS(); LAS float* scr = (LAS float*)(lds + wave * 16384);
          transpose_mat(INP(2) + (size_t)l * D * DIN, D, DIN, WP(W_IN), scr, gw, GW, lane);
          for (int n = 0; n < 3; ++n) transpose_mat(INP(11) + ((size_t)l * 3 + n) * 512 * D, 512, D, WP(W_BR) + (size_t)n * D * 512, scr, gw, GW, lane);
          transpose_mat(INP(12) + (size_t)l * D * D, D, D, WP(W_MIX), scr, gw, GW, lane);
          transpose_mat(INP(15) + (size_t)l * D * 512, D, 512, WP(W_Q), scr, gw, GW, lane);
          transpose_mat(INP(16) + (size_t)l * D * D, D, D, WP(W_KV), scr, gw, GW, lane);
          transpose_mat(INP(17) + (size_t)l * 512 * D, 512, D, WP(W_O), scr, gw, GW, lane);
          transpose_mat(INP(20) + (size_t)l * D * DIN, D, DIN, WP(W_UP), scr, gw, GW, lane);
          transpose_mat(INP(23) + (size_t)l * DFF * D, DFF, D, WP(W_DN), scr, gw, GW, lane); }
        grid.sync();
        run_gemm(lds, (bf16_t*)(WSB + WS_XB), WP(W_IN), T, DIN, D, pg8::FStoreBf16{(bf16_t*)(WSB + WS_R1), DIN, 1.0f});
        grid.sync();
        { TIDS(); unsigned char* ws = WSB;
          prep_phase((bf16_t*)(ws + WS_R1), INP(3) + (size_t)l * 3072, INP(5) + l * 64, INP(6) + l * 64, INP(7) + l * 512, INP(8) + l * 512,
                     (const float*)(ws + WS_COSA), (const float*)(ws + WS_SINA), (const float*)(ws + WS_TABB), gt, GT); }
        grid.sync();
        { TIDS(); unsigned char* ws = WSB; bf16_t* proj = (bf16_t*)(ws + WS_R1); bf16_t* br = (bf16_t*)(ws + WS_R2 + R2_BR);
          naive_attn<1, true>(proj + C_AQ, DIN, proj + C_AK, DIN, proj + C_AV, DIN, br, 512, 8, 2, S, S, 0.125f, INP(4) + l * 8, gt, GT);
          naive_attn<1, false>(proj + C_BQ, DIN, proj + C_BK, DIN, proj + C_BV, DIN, br + (size_t)T * 512, 512, 8, 2, S, S, 0.125f, nullptr, gt, GT);
          naive_gmlp(proj, INP(9) + (size_t)l * 4 * 128 * 128, INP(10) + l * 512, br + (size_t)2 * T * 512, gt, GT); }
        grid.sync();
        for (int n = 0; n < 3; ++n) {
            asm volatile("" : "+s"(n));
            run_gemm(lds, (bf16_t*)(WSB + WS_R2 + R2_BR) + (size_t)n * T * 512, WP(W_BR) + (size_t)n * D * 512, T, D, 512,
                     pg8::FBranch{(bf16_t*)(WSB + WS_R2 + R2_MERGED), (bf16_t*)(WSB + WS_R1) + C_G + n * 1024, DIN, n == 0 ? 1 : 0});
        }
        grid.sync();
        run_gemm(lds, (bf16_t*)(WSB + WS_R2 + R2_MERGED), WP(W_MIX), T, D, D, pg8::FResid{XOUT, (float*)(WSB + WS_R1), ALPHA});
        grid.sync();
        { TIDS(); ln_phase((float*)(WSB + WS_R1), INP(13) + l * D, INP(14) + l * D, XOUT, (bf16_t*)(WSB + WS_XB), gw, GW, lane); }
        grid.sync();
        run_gemm(lds, (bf16_t*)(WSB + WS_XB), WP(W_Q), T, 512, D, pg8::FStoreBf16{(bf16_t*)(WSB + WS_R2 + R2_XQ), 512, 1.0f});
        run_gemm(lds, (bf16_t*)(WSB + WS_MEMB), WP(W_KV), NB * MEM, D, D, pg8::FStoreBf16{(bf16_t*)(WSB + WS_MEMKV), D, 1.0f});
        grid.sync();
        { TIDS(); unsigned char* ws = WSB; bf16_t* memkv = (bf16_t*)(ws + WS_MEMKV);
          naive_attn<2, false>((bf16_t*)(ws + WS_R2 + R2_XQ), 512, memkv, D, memkv + 512, D, (bf16_t*)(ws + WS_R2 + R2_XO), 512, 4, 0, S, MEM, 0.08838834764831845f, nullptr, gt, GT); }
        grid.sync();
        run_gemm(lds, (bf16_t*)(WSB + WS_R2 + R2_XO), WP(W_O), T, D, 512, pg8::FResid{XOUT, (float*)(WSB + WS_R1), ALPHA});
        grid.sync();
        { TIDS(); ln_phase((float*)(WSB + WS_R1), INP(18) + l * D, INP(19) + l * D, XOUT, (bf16_t*)(WSB + WS_XB), gw, GW, lane); }
        grid.sync();
        run_gemm(lds, (bf16_t*)(WSB + WS_XB), WP(W_UP), T, DIN, D, pg8::FStoreBf16{(bf16_t*)(WSB + WS_R1), DIN, 1.0f});
        grid.sync();
        { TIDS(); naive_conv((bf16_t*)(WSB + WS_R1), INP(21) + (size_t)l * 3 * DIN, INP(22) + (size_t)l * DIN, (bf16_t*)(WSB + WS_R2 + R2_G), gt, GT); }
        grid.sync();
        run_gemm(lds, (bf16_t*)(WSB + WS_R2 + R2_G), WP(W_DN), T, D, DFF, pg8::FResid{XOUT, (float*)(WSB + WS_R1), ALPHA});
        grid.sync();
        { TIDS(); ln_phase((float*)(WSB + WS_R1), INP(24) + l * D, INP(25) + l * D, XOUT, (bf16_t*)(WSB + WS_XB), gw, GW, lane); }
        grid.sync();
    }
}

extern "C" void kernel_launch(void* const* d_in, const int* in_sizes, int n_in, void* d_out, int out_size, void* d_ws, size_t ws_size, hipStream_t stream) {
    static int grid = 0;
    if (grid == 0) {
        if (n_in != 26 || out_size != T * D || ws_size < WS_END) { fprintf(stderr, "kernel_launch: unexpected shapes / workspace (n_in %d out %d ws %zu)\n", n_in, out_size, ws_size); grid = -1; return; }
        int dev = 0, cus = 0, per_cu = 0;
        hipGetDevice(&dev); hipDeviceGetAttribute(&cus, hipDeviceAttributeMultiprocessorCount, dev);
        hipFuncSetAttribute((const void*)fwd_kernel, hipFuncAttributeMaxDynamicSharedMemorySize, LDS_BYTES);
        hipOccupancyMaxActiveBlocksPerMultiprocessor(&per_cu, (const void*)fwd_kernel, 512, LDS_BYTES);
        if (per_cu < 1) per_cu = 1;
        (void)hipGetLastError();
        grid = cus * per_cu;
    }
    if (grid < 0) return;
    Args a{};
    for (int i = 0; i < 26; ++i) a.in[i] = (const float*)d_in[i];
    a.out = (float*)d_out; a.ws = (unsigned char*)d_ws;
    void* args[] = {&a};
    hipError_t e = hipLaunchCooperativeKernel((const void*)fwd_kernel, dim3(grid), dim3(512), args, LDS_BYTES, stream);
    if (e != hipSuccess) fprintf(stderr, "cooperative launch failed: %s (grid %d)\n", hipGetErrorString(e), grid);
}
```

```cpp
#include <hip/hip_runtime.h>
#include <hip/hip_cooperative_groups.h>
#include <cstdio>
#include <cstdint>
namespace cg = cooperative_groups;
namespace pg8 {
#define PG8_LAS __attribute__((address_space(3)))
typedef unsigned short bf16_t;
typedef short bf16x8 __attribute__((ext_vector_type(8)));
typedef float f32x4 __attribute__((ext_vector_type(4)));
typedef unsigned u32x4 __attribute__((ext_vector_type(4)));
constexpr int BM = 256, BK = 64, HALF = 128, HTB = HALF * BK * 2  , STAGE_BYTES = 8 * HTB, NXCD = 8, WGM = 8;

__host__ __device__ __forceinline__ int lds_byte(int r, int c) { const int st = (r >> 4) * 2 + (c >> 5), rr = r & 15, cc = c & 31, ob = rr * 64 + cc * 2; return st * 1024 + (ob ^ (((ob >> 9) & 1) << 5)); }
__host__ __device__ __forceinline__ void stage_rc(int b, int& R, int& C) { const int st = b / 1024, sb = b % 1024, swz = sb ^ (((sb >> 9) & 1) << 5); R = (st >> 1) * 16 + swz / 64; C = (st & 1) * 32 + (swz % 64) / 2; }
__host__ __device__ __forceinline__ int perm32(int rho) { const int n = rho >> 4, i = rho & 15; return 8 * (i >> 2) + 4 * n + (i & 3); }

struct Unit { int pm, pn; };
struct Gemm { const bf16_t* A; const bf16_t* Bt; int M, N, K; };

struct StaticOrder {
    int nM, nN, nwg, G, c;
    __host__ __device__ void init(int M, int N, int G_, int c_) { nM = M / BM; nN = N / BM; nwg = nM * nN; G = G_; c = c_; }
    __host__ __device__ bool next(int i, Unit& u) const {
        const long L = (long)i * G + c; if (L >= nwg) return false;
        int wgid = (int)L; { const int q = nwg / NXCD, r = nwg % NXCD, xcd = wgid % NXCD, off = wgid / NXCD; wgid = (xcd < r ? xcd * (q + 1) : r * (q + 1) + (xcd - r) * q) + off; }
        const int nig = WGM * nN, gid = wgid / nig, fm = gid * WGM, gsz = (nM - fm) < WGM ? (nM - fm) : WGM;
        u.pm = fm + ((wgid % nig) % gsz); u.pn = (wgid % nig) / gsz; return true;
    }
    __device__ __forceinline__ void a_ready(const Unit&) const {}
    __device__ __forceinline__ void done(const Unit&) const {}
};

__device__ __forceinline__ unsigned cvt_pk_bf16(float lo, float hi) { unsigned r; asm volatile("v_cvt_pk_bf16_f32 %0, %1, %2" : "=v"(r) : "v"(lo), "v"(hi)); return r; }
typedef float f32x2 __attribute__((ext_vector_type(2)));
__device__ __forceinline__ f32x2 gelu_pk(f32x2 v) {
    const f32x2 av = __builtin_elementwise_abs(v), d = av * 0.2316418882f + 1.0f;
    f32x2 t; t.x = __builtin_amdgcn_rcpf(d.x); t.y = __builtin_amdgcn_rcpf(d.y);
    f32x2 q = t * 0.5307027145f + (-0.7265760135f); q = q * t + 0.7107068705f; q = q * t + (-0.142248368f); q = q * t + 0.127414796f; q = q * t;
    const f32x2 s = (v * v) * (-0.72134752044f);
    f32x2 e; e.x = __builtin_amdgcn_exp2f(s.x); e.y = __builtin_amdgcn_exp2f(s.y);
    const f32x2 m = v * (q * e), r = v - m;
    f32x2 o; o.x = v.x < 0.f ? m.x : r.x; o.y = v.y < 0.f ? m.y : r.y; return o;
}
__device__ __forceinline__ unsigned f2bf(float f) { unsigned u = __builtin_bit_cast(unsigned, f); return (u + 0x7fffu + ((u >> 16) & 1u)) >> 16; }
__device__ __forceinline__ unsigned pk2(float lo, float hi) { return f2bf(lo) | (f2bf(hi) << 16); }
__device__ __forceinline__ u32x4 pack8(f32x4 a, f32x4 b) { u32x4 w; w.x = pk2(a[0], a[1]); w.y = pk2(a[2], a[3]); w.z = pk2(b[0], b[1]); w.w = pk2(b[2], b[3]); return w; }
__device__ __forceinline__ float bflo(unsigned w) { return __builtin_bit_cast(float, w << 16); }
__device__ __forceinline__ float bfhi(unsigned w) { return __builtin_bit_cast(float, w & 0xffff0000u); }
template <class F> struct EpiRow8 {
    static constexpr bool PERM = true, AFTER_DRAIN = false;
    F f;
    __device__ __forceinline__ void operator()(const f32x4 (&acc)[2][2][4][2], const Unit& u, int wr, int wc, int fr, int fq) const {
#pragma unroll
        for (int ai = 0; ai < 2; ++ai)
#pragma unroll
            for (int m = 0; m < 4; ++m) {
                const int row = u.pm * BM + ai * HALF + wr * 64 + m * 16 + fr;
#pragma unroll
                for (int bj = 0; bj < 2; ++bj) {
                    const int col = u.pn * BM + bj * HALF + wc * 32 + 8 * fq;
                    f(row, col, acc[ai][bj][m][0], acc[ai][bj][m][1]);
                }
                asm volatile("" ::: "memory");
            }
    }
};
struct FStoreBf16 { bf16_t* O; int ldc; float scale;
    __device__ __forceinline__ void operator()(int row, int col, f32x4 v0, f32x4 v1) const {
        *(u32x4*)(O + (size_t)row * ldc + col) = pack8(v0 * scale, v1 * scale); } };
struct FBranch { bf16_t* Mg; const bf16_t* G; int ldg; int first;
    __device__ __forceinline__ void operator()(int row, int col, f32x4 v0, f32x4 v1) const {
        const u32x4 g = *(const u32x4*)(G + (size_t)row * ldg + col);
        f32x4 g0 = {bflo(g.x), bfhi(g.x), bflo(g.y), bfhi(g.y)}, g1 = {bflo(g.z), bfhi(g.z), bflo(g.w), bfhi(g.w)};
        v0 = v0 * g0; v1 = v1 * g1;
        bf16_t* mp = Mg + (size_t)row * 1024 + col;
        if (!first) { const u32x4 o = *(const u32x4*)mp; v0 += (f32x4){bflo(o.x), bfhi(o.x), bflo(o.y), bfhi(o.y)}; v1 += (f32x4){bflo(o.z), bfhi(o.z), bflo(o.w), bfhi(o.w)}; }
        *(u32x4*)mp = pack8(v0, v1); } };
struct FResid { const float* X; float* Y; float alpha;
    __device__ __forceinline__ void operator()(int row, int col, f32x4 v0, f32x4 v1) const {
        const size_t o = (size_t)row * 1024 + col;
        const f32x4 x0 = *(const f32x4*)(X + o), x1 = *(const f32x4*)(X + o + 4);
        *(f32x4*)(Y + o) = x0 * alpha + v0; *(f32x4*)(Y + o + 4) = x1 * alpha + v1; } };
struct FStoreKV { bf16_t* K; bf16_t* Vt;
    __device__ __forceinline__ void operator()(int row, int col, f32x4 v0, f32x4 v1) const {
        if (col < 512) { *(u32x4*)(K + (size_t)row * 512 + col) = pack8(v0, v1); }
        else { const int c2 = col - 512, h = c2 >> 7, d = c2 & 127, b = row >> 8, mm = row & 255; bf16_t* p = Vt + ((size_t)((b * 4 + h) * 128 + d)) * 256 + mm;
            p[0 * 256] = (bf16_t)f2bf(v0[0]); p[1 * 256] = (bf16_t)f2bf(v0[1]); p[2 * 256] = (bf16_t)f2bf(v0[2]); p[3 * 256] = (bf16_t)f2bf(v0[3]);
            p[4 * 256] = (bf16_t)f2bf(v1[0]); p[5 * 256] = (bf16_t)f2bf(v1[1]); p[6 * 256] = (bf16_t)f2bf(v1[2]); p[7 * 256] = (bf16_t)f2bf(v1[3]); } } };
template <class Epi, class Sched, bool ALIGN_EPI = false, bool SP2 = false>
__device__ __forceinline__ void gemm_phase(PG8_LAS unsigned char* lds, const Gemm g, const Sched& S, const Epi& E) {
    int tid_l = threadIdx.x; asm volatile("" : "+v"(tid_l));
    const int tid = tid_l, wid = __builtin_amdgcn_readfirstlane(tid >> 6), lane = tid & 63, wr = wid >> 2, wc = wid & 3, fr = lane & 15, fq = lane >> 4;
    const int K = g.K, nt = K / BK;
    unsigned voffA[2], voffB[2];
#pragma unroll
    for (int i = 0; i < 2; ++i) { int R, C; stage_rc(tid * 16 + i * 8192, R, C); const int Rb = Epi::PERM ? ((R & ~31) + perm32(R & 31)) : R;
        voffA[i] = (unsigned)(R * K + C) * 2u; voffB[i] = (unsigned)(Rb * K + C) * 2u; }
    const size_t kstep = (size_t)(BK * 2);
    const size_t hstep = (size_t)HALF * K * 2;
    const size_t tstep = 2 * hstep;
    const unsigned ldsw = (unsigned)wid * 1024u;
    const int aoff = lds_byte(wr * 64 + fr, fq * 8), boff = lds_byte(wc * 32 + fr, fq * 8);
#define PG8_SA(b, h) (((b) * 2 + (h)) * HTB)
#define PG8_SB(b, h) ((4 + (b) * 2 + (h)) * HTB)
#define PG8_STAGE(bufoff, gbase, voff) do { _Pragma("unroll") for (int _i = 0; _i < 2; ++_i) \
        __builtin_amdgcn_global_load_lds((const unsigned*)((const char*)(gbase) + (voff)[_i]), (PG8_LAS unsigned*)(lds + (bufoff) + ldsw + _i * 8192), 16, 0, 0); } while (0)
#define PG8_LDA(dst, b, h) do { _Pragma("unroll") for (int m = 0; m < 4; ++m) _Pragma("unroll") for (int k = 0; k < 2; ++k) dst[m][k] = *(const PG8_LAS bf16x8*)(lds + PG8_SA(b, h) + aoff + m * 2048 + k * 1024); } while (0)
#define PG8_LDB(dst, b, h) do { _Pragma("unroll") for (int n = 0; n < 2; ++n) _Pragma("unroll") for (int k = 0; k < 2; ++k) dst[n][k] = *(const PG8_LAS bf16x8*)(lds + PG8_SB(b, h) + boff + n * 2048 + k * 1024); } while (0)
#define PG8_MMA(ai, bj, At, Bt) do { __builtin_amdgcn_s_setprio(1); _Pragma("unroll") for (int m = 0; m < 4; ++m) _Pragma("unroll") for (int n = 0; n < 2; ++n) _Pragma("unroll") for (int k = 0; k < 2; ++k) \
        acc[ai][bj][m][n] = __builtin_amdgcn_mfma_f32_16x16x32_bf16(Bt[n][k], At[m][k], acc[ai][bj][m][n], 0, 0, 0); __builtin_amdgcn_s_setprio(0); } while (0)
#define PG8_WAIT_V(n) asm volatile("s_waitcnt vmcnt(" #n ")" ::: "memory")
#define PG8_WAIT_L(n) asm volatile("s_waitcnt lgkmcnt(" #n ")" ::: "memory")
#define PG8_BAR __builtin_amdgcn_s_barrier()
#define PG8_SCHED __builtin_amdgcn_sched_barrier(0)
    Unit cur, nxt; int ui = 0;
    if (!S.next(0, cur)) return;
    f32x4 acc[2][2][4][2];
#pragma unroll
    for (int a = 0; a < 2; ++a)
#pragma unroll
        for (int b = 0; b < 2; ++b)
#pragma unroll
            for (int m = 0; m < 4; ++m)
#pragma unroll
                for (int n = 0; n < 2; ++n) acc[a][b][m][n] = (f32x4){0.f, 0.f, 0.f, 0.f};
    bf16x8 At[4][2], B0[2][2], B1[2][2];
    const char* cA = (const char*)g.A + (size_t)cur.pm * tstep; const char* cB = (const char*)g.Bt + (size_t)cur.pn * tstep;
    S.a_ready(cur);
    if constexpr (SP2) {
        PG8_STAGE(PG8_SB(0, 0), cB, voffB); PG8_STAGE(PG8_SB(0, 1), cB + hstep, voffB); PG8_STAGE(PG8_SA(0, 0), cA, voffA); PG8_STAGE(PG8_SA(0, 1), cA + hstep, voffA);
        if (wr == 1) PG8_BAR;
        PG8_WAIT_V(2); PG8_BAR;
        PG8_STAGE(PG8_SB(1, 0), cB + kstep, voffB); PG8_STAGE(PG8_SA(1, 0), cA + kstep, voffA); PG8_STAGE(PG8_SB(1, 1), cB + hstep + kstep, voffB);
        PG8_WAIT_V(6); PG8_BAR;
    } else {
        PG8_STAGE(PG8_SB(0, 0), cB, voffB); PG8_STAGE(PG8_SA(0, 0), cA, voffA); PG8_STAGE(PG8_SB(0, 1), cB + hstep, voffB); PG8_STAGE(PG8_SA(0, 1), cA + hstep, voffA);
        if (wr == 1) PG8_BAR;
        PG8_WAIT_V(4); PG8_BAR;
        PG8_STAGE(PG8_SB(1, 0), cB + kstep, voffB); PG8_STAGE(PG8_SA(1, 0), cA + kstep, voffA); PG8_STAGE(PG8_SB(1, 1), cB + hstep + kstep, voffB);
        PG8_WAIT_V(6); PG8_BAR;
    }
    for (;;) {
        const bool has_next = S.next(ui + 1, nxt);
        const char* nA = has_next ? (const char*)g.A + (size_t)nxt.pm * tstep : cA; const char* nB = has_next ? (const char*)g.Bt + (size_t)nxt.pn * tstep : cB;
        for (int t = 0; t < nt; t += 2) {
            const bool last = (t == nt - 2);
            const char* a1 = cA + (size_t)(t + 1) * kstep;
            const char* a2 = last ? nA : cA + (size_t)(t + 2) * kstep; const char* b2 = last ? nB : cB + (size_t)(t + 2) * kstep;
            const char* a3 = a2 + kstep; const char* b3 = b2 + kstep;
            if (last && has_next) S.a_ready(nxt);
            if constexpr (SP2) {
            PG8_LDB(B0, 0, 0); PG8_LDB(B1, 0, 1); PG8_SCHED; PG8_LDA(At, 0, 0); PG8_STAGE(PG8_SA(1, 1), a1 + hstep, voffA);
            PG8_WAIT_V(8); PG8_WAIT_L(0); PG8_BAR; PG8_MMA(0, 0, At, B0); PG8_MMA(0, 1, At, B1); PG8_BAR; PG8_SCHED;
            PG8_LDA(At, 0, 1); PG8_STAGE(PG8_SB(0, 0), b2, voffB); PG8_STAGE(PG8_SB(0, 1), b2 + hstep, voffB); PG8_STAGE(PG8_SA(0, 0), a2, voffA);
            PG8_WAIT_V(8); PG8_WAIT_L(0); PG8_BAR; PG8_MMA(1, 0, At, B0); PG8_MMA(1, 1, At, B1); PG8_BAR; PG8_SCHED;
            PG8_LDB(B0, 1, 0); PG8_LDB(B1, 1, 1); PG8_SCHED; PG8_LDA(At, 1, 0); PG8_STAGE(PG8_SA(0, 1), a2 + hstep, voffA);
            PG8_WAIT_V(8); PG8_WAIT_L(0); PG8_BAR; PG8_MMA(0, 0, At, B0); PG8_MMA(0, 1, At, B1); PG8_BAR; PG8_SCHED;
            PG8_LDA(At, 1, 1); PG8_STAGE(PG8_SB(1, 0), b3, voffB); PG8_STAGE(PG8_SB(1, 1), b3 + hstep, voffB); PG8_STAGE(PG8_SA(1, 0), a3, voffA);
            PG8_WAIT_V(8); PG8_WAIT_L(0); PG8_BAR; PG8_MMA(1, 0, At, B0); PG8_MMA(1, 1, At, B1); PG8_BAR; PG8_SCHED;
            } else {
            PG8_LDB(B0, 0, 0); PG8_SCHED; PG8_LDA(At, 0, 0); PG8_STAGE(PG8_SA(1, 1), a1 + hstep, voffA);
            PG8_WAIT_L(8); PG8_BAR; PG8_WAIT_L(0); PG8_MMA(0, 0, At, B0); PG8_BAR; PG8_SCHED;
            PG8_LDB(B1, 0, 1); PG8_STAGE(PG8_SB(0, 0), b2, voffB);
            PG8_BAR; PG8_WAIT_L(0); PG8_MMA(0, 1, At, B1); PG8_BAR;
            PG8_LDA(At, 0, 1); PG8_STAGE(PG8_SA(0, 0), a2, voffA);
            PG8_BAR; PG8_WAIT_L(0); PG8_MMA(1, 0, At, B0); PG8_BAR; PG8_SCHED;
            PG8_STAGE(PG8_SB(0, 1), b2 + hstep, voffB);
            PG8_WAIT_V(6); PG8_BAR; PG8_MMA(1, 1, At, B1); PG8_BAR;
            PG8_LDB(B0, 1, 0); PG8_SCHED; PG8_LDA(At, 1, 0); PG8_STAGE(PG8_SA(0, 1), a2 + hstep, voffA);
            PG8_WAIT_L(8); PG8_BAR; PG8_WAIT_L(0); PG8_MMA(0, 0, At, B0); PG8_BAR; PG8_SCHED;
            PG8_LDB(B1, 1, 1); PG8_STAGE(PG8_SB(1, 0), b3, voffB);
            PG8_BAR; PG8_WAIT_L(0); PG8_MMA(0, 1, At, B1); PG8_BAR;
            PG8_LDA(At, 1, 1); PG8_STAGE(PG8_SA(1, 0), a3, voffA);
            PG8_BAR; PG8_WAIT_L(0); PG8_MMA(1, 0, At, B0); PG8_BAR; PG8_SCHED;
            PG8_STAGE(PG8_SB(1, 1), b3 + hstep, voffB);
            PG8_WAIT_V(6); PG8_BAR; PG8_MMA(1, 1, At, B1); PG8_BAR;
            }
        }
        if constexpr (ALIGN_EPI) { if (wr == 0) PG8_BAR; }
        if constexpr (!Epi::AFTER_DRAIN) { E(acc, cur, wr, wc, fr, fq); S.done(cur); }
        if (!has_next) break;
#pragma unroll
        for (int a = 0; a < 2; ++a)
#pragma unroll
            for (int b = 0; b < 2; ++b)
#pragma unroll
                for (int m = 0; m < 4; ++m)
#pragma unroll
                    for (int n = 0; n < 2; ++n) acc[a][b][m][n] = (f32x4){0.f, 0.f, 0.f, 0.f};
        cur = nxt; cA = nA; cB = nB; ++ui;
        if constexpr (ALIGN_EPI) { if (wr == 1) PG8_BAR; }
    }
    PG8_WAIT_V(0);
    if constexpr (!ALIGN_EPI) { if (wr == 0) PG8_BAR; }
    PG8_BAR;
    if constexpr (Epi::AFTER_DRAIN) { E.fused(acc, cur, wr, wc, fr, fq, lds, wid, lane); S.done(cur); }
#undef PG8_SA
#undef PG8_SB
#undef PG8_STAGE
#undef PG8_LDA
#undef PG8_LDB
#undef PG8_MMA
#undef PG8_WAIT_V
#undef PG8_WAIT_L
#undef PG8_BAR
#undef PG8_SCHED
}
}
using pg8::bf16_t; using pg8::f32x4; using pg8::u32x4;
#define LAS __attribute__((address_space(3)))
constexpr int NB = 4, S = 4096, T = NB * S, D = 1024, DIN = 5632, DEPTH = 4, DFF = 2816, MEM = 256;
constexpr int C_AQ = 0, C_AK = 512, C_AV = 640, C_BQ = 768, C_BK = 1280, C_BV = 1408, C_U = 1536, C_V = 2048, C_G = 2560;
constexpr float ALPHA = 1.681792830507429f;
constexpr float LN_EPS = 1e-5f, RMS_EPS = 1e-6f;
constexpr size_t MiB = 1u << 20;
constexpr size_t WS_COSA = 0, WS_SINA = 512 * 1024, WS_TABB = 1 * MiB;
constexpr size_t WS_W = 2 * MiB;
constexpr size_t W_IN = 0, W_BR = W_IN + (size_t)DIN * D * 2, W_MIX = W_BR + 3u * D * 512 * 2, W_Q = W_MIX + (size_t)D * D * 2, W_KV = W_Q + 512u * D * 2,
                 W_O = W_KV + (size_t)D * D * 2, W_UP = W_O + (size_t)D * 512 * 2, W_DN = W_UP + (size_t)DIN * D * 2, W_END = W_DN + (size_t)D * DFF * 2;
static_assert(W_END <= 38 * MiB, "weights");
constexpr size_t WS_MEMB = 40 * MiB, WS_MEMKV = 42 * MiB, WS_XB = 44 * MiB, WS_R1 = 76 * MiB, WS_R2 = 252 * MiB, WS_END = 348 * MiB;
constexpr size_t R2_BR = 0, R2_MERGED = 48 * MiB, R2_VT = 48 * MiB, R2_XQ = 80 * MiB, R2_XO = 0, R2_G = 0;
constexpr int LDS_BYTES = 147456;

struct Args { const float* in[26]; float* out; unsigned char* ws; };

__device__ __forceinline__ float bf2f(bf16_t b) { return __builtin_bit_cast(float, (unsigned)b << 16); }
__device__ __forceinline__ bf16_t f2b(float f) { return (bf16_t)pg8::f2bf(f); }
__device__ __forceinline__ float wave_sum(float v) {
#pragma unroll
    for (int o = 1; o < 64; o <<= 1) v += __shfl_xor(v, o);
    return v;
}
__device__ __forceinline__ float gelu_exact(float x) { return 0.5f * x * (1.0f + erff(x * 0.70710678118654752f)); }

__device__ __forceinline__ void transpose_item(const float* W, int K, int N, bf16_t* WT, LAS float* scr, int item, int lane) {
    const int nblk = N / 32, kb = item / nblk, nb = item % nblk, k0 = 64 * kb, n0 = 32 * nb;
#pragma unroll 8
    for (int i = 0; i < 32; ++i) { const int kk = 2 * i + (lane >> 5); scr[kk * 33 + (lane & 31)] = W[(size_t)(k0 + kk) * N + n0 + (lane & 31)]; }
    asm volatile("s_waitcnt lgkmcnt(0)" ::: "memory");
    const int c = lane & 7;
#pragma unroll
    for (int j = 0; j < 4; ++j) { const int n = (lane >> 3) + 8 * j; const LAS float* s = scr + (8 * c) * 33 + n;
        u32x4 o; o.x = pg8::pk2(s[0 * 33], s[1 * 33]); o.y = pg8::pk2(s[2 * 33], s[3 * 33]); o.z = pg8::pk2(s[4 * 33], s[5 * 33]); o.w = pg8::pk2(s[6 * 33], s[7 * 33]);
        *(u32x4*)(WT + (size_t)(n0 + n) * K + k0 + 8 * c) = o; }
    asm volatile("s_waitcnt lgkmcnt(0)" ::: "memory");
}
__device__ __forceinline__ void transpose_mat(const float* W, int K, int N, bf16_t* WT, LAS float* scr, int gw, int GW, int lane) {
    const int nit = (K / 64) * (N / 32);
    for (int it = gw; it < nit; it += GW) transpose_item(W, K, N, WT, scr, it, lane);
}

__device__ __forceinline__ void ln_phase(const float* y, const float* g, const float* b, float* xo, bf16_t* xb, int gw, int GW, int lane) {
    for (int r = gw; r < T; r += GW) {
        const f32x4* yr = (const f32x4*)(y + (size_t)r * D) + lane;
        f32x4 v[4]; float s = 0.f;
#pragma unroll
        for (int j = 0; j < 4; ++j) { v[j] = yr[64 * j]; s += (v[j].x + v[j].y) + (v[j].z + v[j].w); }
        const float mean = wave_sum(s) * (1.f / D); float s2 = 0.f;
#pragma unroll
        for (int j = 0; j < 4; ++j) { v[j] = v[j] - mean; s2 += (v[j].x * v[j].x + v[j].y * v[j].y) + (v[j].z * v[j].z + v[j].w * v[j].w); }
        const float rstd = 1.f / sqrtf(wave_sum(s2) * (1.f / D) + LN_EPS);
#pragma unroll
        for (int j = 0; j < 4; ++j) { const int col = 4 * lane + 256 * j; const f32x4 gg = *(const f32x4*)(g + col), bb = *(const f32x4*)(b + col);
            const f32x4 o = v[j] * rstd * gg + bb;
            *(f32x4*)(xo + (size_t)r * D + col) = o;
            *(unsigned long long*)(xb + (size_t)r * D + col) = (unsigned long long)pg8::pk2(o.x, o.y) | ((unsigned long long)pg8::pk2(o.z, o.w) << 32); }
    }
}

__device__ __forceinline__ void prep_phase(bf16_t* proj, const float* bgate, const float* qgain, const float* kgain, const float* lng, const float* lnb,
                                           const float* cosA, const float* sinA, const float* tabB, int gt, int GT) {
    const int lane = gt & 63, gw = gt >> 6, GW = GT >> 6;
    for (int unit = gt; unit < T * 20; unit += GT) {
        const int t = unit / 20, hh = unit % 20, s = t % S;
        bf16_t* row = proj + (size_t)t * DIN;
        if (hh < 10) {
            bf16_t* p = row + hh * 64; const float* c = cosA + s * 32; const float* sn = sinA + s * 32;
            for (int i = 0; i < 32; ++i) { const float x1 = bf2f(p[i]), x2 = bf2f(p[i + 32]); p[i] = f2b(x1 * c[i] - x2 * sn[i]); p[i + 32] = f2b(x2 * c[i] + x1 * sn[i]); }
        } else {
            const int hb = hh - 10; bf16_t* p = row + C_BQ + hb * 64; const float* gain = hb < 8 ? qgain : kgain;
            float ss = 0.f; for (int i = 0; i < 64; ++i) { const float x = bf2f(p[i]); ss += x * x; }
            const float rstd = 1.0f / sqrtf(ss * (1.f / 64.f) + RMS_EPS);
            const int r = s / 64, cc = s % 64;
            for (int i = 0; i < 16; ++i) { const float x1 = bf2f(p[i]) * rstd * gain[i], x2 = bf2f(p[i + 16]) * rstd * gain[i + 16]; const float c = tabB[r * 16 + i], sn = tabB[1024 + r * 16 + i];
                p[i] = f2b(x1 * c - x2 * sn); p[i + 16] = f2b(x2 * c + x1 * sn); }
            for (int i = 0; i < 16; ++i) { const float x1 = bf2f(p[32 + i]) * rstd * gain[32 + i], x2 = bf2f(p[48 + i]) * rstd * gain[48 + i]; const float c = tabB[cc * 16 + i], sn = tabB[1024 + cc * 16 + i];
                p[32 + i] = f2b(x1 * c - x2 * sn); p[48 + i] = f2b(x2 * c + x1 * sn); }
        }
    }
    for (int unit = gt; unit < T * 448; unit += GT) {
        const int t = unit / 448, ch = unit % 448;
        const int col = ch < 64 ? C_U + ch * 8 : C_G + (ch - 64) * 8;
        u32x4* p = (u32x4*)(proj + (size_t)t * DIN + col); const u32x4 w = *p;
        float v[8] = {pg8::bflo(w.x), pg8::bfhi(w.x), pg8::bflo(w.y), pg8::bfhi(w.y), pg8::bflo(w.z), pg8::bfhi(w.z), pg8::bflo(w.w), pg8::bfhi(w.w)};
        if (ch < 64) {
#pragma unroll
            for (int e = 0; e < 8; ++e) v[e] = gelu_exact(v[e]);
        } else {
#pragma unroll
            for (int e = 0; e < 8; ++e) v[e] = 1.0f / (1.0f + __expf(-(v[e] + bgate[col - C_G + e])));
        }
        u32x4 o; o.x = pg8::pk2(v[0], v[1]); o.y = pg8::pk2(v[2], v[3]); o.z = pg8::pk2(v[4], v[5]); o.w = pg8::pk2(v[6], v[7]); *p = o;
    }
    for (int t = gw; t < T; t += GW) {
        u32x4* p = (u32x4*)(proj + (size_t)t * DIN + C_V + lane * 8); const u32x4 w = *p;
        float v[8] = {pg8::bflo(w.x), pg8::bfhi(w.x), pg8::bflo(w.y), pg8::bfhi(w.y), pg8::bflo(w.z), pg8::bfhi(w.z), pg8::bflo(w.w), pg8::bfhi(w.w)};
        float s = 0.f;
#pragma unroll
        for (int e = 0; e < 8; ++e) { v[e] = gelu_exact(v[e]); s += v[e]; }
        const float mean = wave_sum(s) * (1.f / 512.f); float s2 = 0.f;
#pragma unroll
        for (int e = 0; e < 8; ++e) { v[e] -= mean; s2 += v[e] * v[e]; }
        const float rstd = 1.0f / sqrtf(wave_sum(s2) * (1.f / 512.f) + LN_EPS);
#pragma unroll
        for (int e = 0; e < 8; ++e) v[e] = v[e] * rstd * lng[lane * 8 + e] + lnb[lane * 8 + e];
        u32x4 o; o.x = pg8::pk2(v[0], v[1]); o.y = pg8::pk2(v[2], v[3]); o.z = pg8::pk2(v[4], v[5]); o.w = pg8::pk2(v[6], v[7]); *p = o;
    }
}


__device__ __forceinline__ void make_vt(const bf16_t* proj, bf16_t* vt, int gt, int GT) {
    for (int idx = gt; idx < 2 * NB * 2 * 64 * S; idx += GT) {
        const int s = idx % S, d = (idx / S) % 64, kvh = (idx / (S * 64)) % 2, b = (idx / (S * 128)) % NB, ab = idx / (S * 128 * NB);
        vt[idx] = proj[(size_t)(b * S + s) * DIN + (ab ? C_BV : C_AV) + kvh * 64 + d];
    }
}

template <int NP, bool WINDOW>
__device__ __forceinline__ void naive_attn(const bf16_t* Q, int qp, const bf16_t* Kp, int kp, const bf16_t* Vp, int vp, bf16_t* O, int op,
                                           int H, int hshift, int Sq, int Skv, float scale, const float* sink, int gt, int GT) {
    constexpr int HD = 64 * NP;
    for (int unit = gt; unit < H * T * NP; unit += GT) {
        const int part = unit % NP, t = (unit / NP) % T, h = unit / (NP * T), b = t / Sq, s = t % Sq, kvh = h >> hshift;
        float q[64], o[64];
        { const u32x4* qv = (const u32x4*)(Q + (size_t)t * qp + h * HD + part * 64);
#pragma unroll
          for (int c = 0; c < 8; ++c) { const u32x4 w = qv[c]; q[c * 8 + 0] = pg8::bflo(w.x) * scale; q[c * 8 + 1] = pg8::bfhi(w.x) * scale; q[c * 8 + 2] = pg8::bflo(w.y) * scale; q[c * 8 + 3] = pg8::bfhi(w.y) * scale;
              q[c * 8 + 4] = pg8::bflo(w.z) * scale; q[c * 8 + 5] = pg8::bfhi(w.z) * scale; q[c * 8 + 6] = pg8::bflo(w.w) * scale; q[c * 8 + 7] = pg8::bfhi(w.w) * scale; } }
#pragma unroll
        for (int d = 0; d < 64; ++d) o[d] = 0.f;
        float m = WINDOW ? sink[h] : -1e30f, l = WINDOW ? 1.f : 0.f;
        const int s0 = s & ~63;
        const int jlo = WINDOW ? (s0 - 128 > 0 ? s0 - 128 : 0) : 0, jhi = WINDOW ? (s0 + 191 < Skv - 1 ? s0 + 191 : Skv - 1) : Skv - 1;
        for (int j = jlo; j <= jhi; ++j) {
            const u32x4* kv = (const u32x4*)(Kp + (size_t)(b * Skv + j) * kp + kvh * HD + part * 64);
            float sc = 0.f;
#pragma unroll
            for (int c = 0; c < 8; ++c) { const u32x4 w = kv[c];
                sc += q[c * 8 + 0] * pg8::bflo(w.x) + q[c * 8 + 1] * pg8::bfhi(w.x) + q[c * 8 + 2] * pg8::bflo(w.y) + q[c * 8 + 3] * pg8::bfhi(w.y)
                    + q[c * 8 + 4] * pg8::bflo(w.z) + q[c * 8 + 5] * pg8::bfhi(w.z) + q[c * 8 + 6] * pg8::bflo(w.w) + q[c * 8 + 7] * pg8::bfhi(w.w); }
            if (NP == 2) sc += __shfl_xor(sc, 1);
            const int dj = s - j; const bool valid = !WINDOW || (dj <= 128 && dj >= -128);
            if (valid) {
                const float mn = fmaxf(m, sc), f = __expf(m - mn), p = __expf(sc - mn);
                l = l * f + p; m = mn;
                const u32x4* vv = (const u32x4*)(Vp + (size_t)(b * Skv + j) * vp + kvh * HD + part * 64);
#pragma unroll
                for (int c = 0; c < 8; ++c) { const u32x4 w = vv[c];
                    o[c * 8 + 0] = o[c * 8 + 0] * f + p * pg8::bflo(w.x); o[c * 8 + 1] = o[c * 8 + 1] * f + p * pg8::bfhi(w.x); o[c * 8 + 2] = o[c * 8 + 2] * f + p * pg8::bflo(w.y); o[c * 8 + 3] = o[c * 8 + 3] * f + p * pg8::bfhi(w.y);
                    o[c * 8 + 4] = o[c * 8 + 4] * f + p * pg8::bflo(w.z); o[c * 8 + 5] = o[c * 8 + 5] * f + p * pg8::bfhi(w.z); o[c * 8 + 6] = o[c * 8 + 6] * f + p * pg8::bflo(w.w); o[c * 8 + 7] = o[c * 8 + 7] * f + p * pg8::bfhi(w.w); }
            }
        }
        const float il = 1.0f / l;
        u32x4* ov = (u32x4*)(O + (size_t)t * op + h * HD + part * 64);
#pragma unroll
        for (int c = 0; c < 8; ++c) { u32x4 w; w.x = pg8::pk2(o[c * 8 + 0] * il, o[c * 8 + 1] * il); w.y = pg8::pk2(o[c * 8 + 2] * il, o[c * 8 + 3] * il); w.z = pg8::pk2(o[c * 8 + 4] * il, o[c * 8 + 5] * il); w.w = pg8::pk2(o[c * 8 + 6] * il, o[c * 8 + 7] * il); ov[c] = w; }
    }
}


typedef short bf16x8 __attribute__((ext_vector_type(8)));
typedef float f32x16 __attribute__((ext_vector_type(16)));
typedef unsigned long long u64;
__device__ __forceinline__ int crow(int r, int hi) { return (r & 3) + 8 * (r >> 2) + 4 * hi; }
template <int HD, bool WINDOW>
__device__ __forceinline__ void fa_unit(LAS unsigned char* lds, const bf16_t* Qp, int qp, const bf16_t* Kp, int kp, const bf16_t* Vt, int Skv,
                                        bf16_t* Op, int op, int t_lo, int t_hi, int q0, float c, float sink2) {
    constexpr int KROW = HD * 2 + 16, KT = 64 * KROW, VTB = HD * 144, BUF = KT + VTB, NI = HD / 64, ND0 = HD / 16, NOB = HD / 32;
    int tid_ = threadIdx.x; asm volatile("" : "+v"(tid_));
    const int tid = tid_, lane = tid & 63, w = __builtin_amdgcn_readfirstlane(tid >> 6), r32 = lane & 31, hi = lane >> 5;
    const bf16_t* kg[NI]; const bf16_t* vg[NI]; unsigned kl[NI], vl[NI];
#pragma unroll
    for (int i = 0; i < NI; ++i) {
        const int ci = tid + 512 * i, row = ci / (HD / 8), cc = ci % (HD / 8);
        kg[i] = Kp + (size_t)row * kp + cc * 8; kl[i] = row * KROW + cc * 16;
        const int d = ci >> 3, c8 = ci & 7, blk = c8 >> 2, j = c8 & 3, pos = 32 * blk + 16 * (j >> 1) + 4 * (j & 1);
        vg[i] = Vt + (size_t)d * Skv + c8 * 8; vl[i] = KT + d * 144 + pos * 2;
    }
    bf16x8 qf[ND0];
#pragma unroll
    for (int d0 = 0; d0 < ND0; ++d0) qf[d0] = *(const bf16x8*)(Qp + (size_t)(32 * w + r32) * qp + 16 * d0 + 8 * hi);
    f32x16 o[NOB];
#pragma unroll
    for (int ob = 0; ob < NOB; ++ob)
#pragma unroll
        for (int r = 0; r < 16; ++r) o[ob][r] = 0.f;
    float m = WINDOW ? sink2 : -1e30f, l = (WINDOW && hi == 0) ? 1.f : 0.f;
    u32x4 kr[NI], vr[NI];
#pragma unroll
    for (int i = 0; i < NI; ++i) { kr[i] = *(const u32x4*)(kg[i] + (size_t)t_lo * 64 * kp); vr[i] = *(const u32x4*)(vg[i] + t_lo * 64); }
#pragma unroll
    for (int i = 0; i < NI; ++i) { *(LAS u32x4*)(lds + kl[i]) = kr[i];
        *(LAS u64*)(lds + vl[i]) = (u64)vr[i].x | ((u64)vr[i].y << 32); *(LAS u64*)(lds + vl[i] + 16) = (u64)vr[i].z | ((u64)vr[i].w << 32); }
    __syncthreads();
    int cur = 0;
#pragma nounroll
    for (int t = t_lo; t <= t_hi; ++t) {
        const bool more = t < t_hi;
        if (more && HD == 64) {
#pragma unroll
            for (int i = 0; i < NI; ++i) { kr[i] = *(const u32x4*)(kg[i] + (size_t)(t + 1) * 64 * kp); vr[i] = *(const u32x4*)(vg[i] + (t + 1) * 64); }
        }
        LAS unsigned char* kb = lds + cur * BUF; LAS unsigned char* vb = kb + KT;
        f32x16 p[2];
#pragma unroll
        for (int blk = 0; blk < 2; ++blk) {
#pragma unroll
            for (int r = 0; r < 16; ++r) p[blk][r] = 0.f;
#pragma unroll
            for (int d0 = 0; d0 < ND0; ++d0) { const bf16x8 kf = *(const LAS bf16x8*)(kb + (32 * blk + r32) * KROW + (16 * d0 + 8 * hi) * 2);
                p[blk] = __builtin_amdgcn_mfma_f32_32x32x16_bf16(kf, qf[d0], p[blk], 0, 0, 0); }
            if (HD > 64) __builtin_amdgcn_sched_barrier(0);
        }
#pragma unroll
        for (int blk = 0; blk < 2; ++blk)
#pragma unroll
            for (int r = 0; r < 16; ++r) p[blk][r] *= c;
        if (WINDOW) {
            const int qw = q0 + 32 * w, j0 = 64 * t;
            if (!(qw + 31 - j0 <= 128 && j0 + 63 - qw <= 128)) {
                const int base = qw + r32 - j0 - 4 * hi;
#pragma unroll
                for (int blk = 0; blk < 2; ++blk)
#pragma unroll
                    for (int r = 0; r < 16; ++r) { const int dj = base - (32 * blk + (r & 3) + 8 * (r >> 2)); if (dj > 128 || dj < -128) p[blk][r] = -1e30f; }
            }
        }
        float tm = p[0][0];
#pragma unroll
        for (int r = 1; r < 16; ++r) tm = fmaxf(tm, p[0][r]);
#pragma unroll
        for (int r = 0; r < 16; ++r) tm = fmaxf(tm, p[1][r]);
        tm = fmaxf(tm, __shfl_xor(tm, 32));
        const float mn = fmaxf(m, tm), f = __builtin_amdgcn_exp2f(m - mn); m = mn;
        if (__any(f != 1.0f)) {
#pragma unroll
            for (int ob = 0; ob < NOB; ++ob)
#pragma unroll
                for (int r = 0; r < 16; ++r) o[ob][r] *= f;
        }
        float rs = 0.f;
#pragma unroll
        for (int blk = 0; blk < 2; ++blk)
#pragma unroll
            for (int r = 0; r < 16; ++r) { const float pe = __builtin_amdgcn_exp2f(p[blk][r] - mn); p[blk][r] = pe; rs += pe; }
        l = l * f + rs;
        bf16x8 pk[2][2];
#pragma unroll
        for (int blk = 0; blk < 2; ++blk)
#pragma unroll
            for (int ks = 0; ks < 2; ++ks) { u32x4 wv; wv.x = pg8::cvt_pk_bf16(p[blk][8 * ks + 0], p[blk][8 * ks + 1]); wv.y = pg8::cvt_pk_bf16(p[blk][8 * ks + 2], p[blk][8 * ks + 3]);
                wv.z = pg8::cvt_pk_bf16(p[blk][8 * ks + 4], p[blk][8 * ks + 5]); wv.w = pg8::cvt_pk_bf16(p[blk][8 * ks + 6], p[blk][8 * ks + 7]); pk[blk][ks] = __builtin_bit_cast(bf16x8, wv); }
#pragma unroll
        for (int ob = 0; ob < NOB; ++ob) {
            if (HD > 64) __builtin_amdgcn_sched_barrier(0);
#pragma unroll
            for (int blk = 0; blk < 2; ++blk)
#pragma unroll
                for (int ks = 0; ks < 2; ++ks) { const bf16x8 vf = *(const LAS bf16x8*)(vb + (32 * ob + r32) * 144 + (32 * blk + 16 * ks + 8 * hi) * 2);
                    o[ob] = __builtin_amdgcn_mfma_f32_32x32x16_bf16(vf, pk[blk][ks], o[ob], 0, 0, 0); }
        }
        if (more) {
            LAS unsigned char* nb = lds + (cur ^ 1) * BUF;
            if (HD > 64) {
                asm volatile("" ::: "memory");
#pragma unroll
                for (int i = 0; i < NI; ++i) { kr[i] = *(const u32x4*)(kg[i] + (size_t)(t + 1) * 64 * kp); vr[i] = *(const u32x4*)(vg[i] + (t + 1) * 64); }
            }
#pragma unroll
            for (int i = 0; i < NI; ++i) { *(LAS u32x4*)(nb + kl[i]) = kr[i];
                *(LAS u64*)(nb + vl[i]) = (u64)vr[i].x | ((u64)vr[i].y << 32); *(LAS u64*)(nb + vl[i] + 16) = (u64)vr[i].z | ((u64)vr[i].w << 32); }
        }
        __syncthreads();
        cur ^= 1;
    }
    l += __shfl_xor(l, 32);
    const float inv = 1.0f / l;
    bf16_t* orow = Op + (size_t)(32 * w + r32) * op + 4 * hi;
#pragma unroll
    for (int ob = 0; ob < NOB; ++ob)
#pragma unroll
        for (int rr = 0; rr < 4; ++rr) {
            const unsigned lo = pg8::cvt_pk_bf16(o[ob][4 * rr + 0] * inv, o[ob][4 * rr + 1] * inv), hh = pg8::cvt_pk_bf16(o[ob][4 * rr + 2] * inv, o[ob][4 * rr + 3] * inv);
            *(u64*)(orow + 32 * ob + 8 * rr) = (u64)lo | ((u64)hh << 32);
        }
}

__device__ __forceinline__ void naive_gmlp(const bf16_t* proj, const float* ws, const float* bs, bf16_t* out, int gt, int GT) {
    for (int unit = gt; unit < T * 512; unit += GT) {
        const int t = unit / 512, ch = unit % 512, g = ch / 128, i = t % 128, tb = t - i;
        const float* w = ws + ((size_t)g * 128 + i) * 128;
        float acc = 0.f;
        for (int j = 0; j < 128; ++j) acc += w[j] * bf2f(proj[(size_t)(tb + j) * DIN + C_V + ch]);
        acc += bs[g * 128 + i];
        out[(size_t)t * 512 + ch] = f2b(bf2f(proj[(size_t)t * DIN + C_U + ch]) * acc);
    }
}

__device__ __forceinline__ void naive_conv(const bf16_t* hup, const float* ck, const float* cb, bf16_t* g, int gt, int GT) {
    for (int unit = gt; unit < T * DFF; unit += GT) {
        const int t = unit / DFF, c = unit % DFF, s = t % S;
        const bf16_t* h0 = hup + (size_t)t * DIN;
        float a = ck[DIN + c] * bf2f(h0[c]) + cb[c], b = ck[DIN + DFF + c] * bf2f(h0[DFF + c]) + cb[DFF + c];
        if (s > 0) { a += ck[c] * bf2f(h0[c - DIN]); b += ck[DFF + c] * bf2f(h0[DFF + c - DIN]); }
        if (s < S - 1) { a += ck[2 * DIN + c] * bf2f(h0[c + DIN]); b += ck[2 * DIN + DFF + c] * bf2f(h0[DFF + c + DIN]); }
        g[(size_t)t * DFF + c] = f2b(gelu_exact(a) * b);
    }
}

template <class F> __device__ __forceinline__ void run_gemm(LAS unsigned char* lds, const bf16_t* A, const bf16_t* Bt, int M, int N, int K, const F& f) {
    pg8::Gemm g{A, Bt, M, N, K}; pg8::StaticOrder So; So.init(M, N, (int)gridDim.x, (int)blockIdx.x);
    pg8::EpiRow8<F> E{f};
    pg8::gemm_phase<pg8::EpiRow8<F>, pg8::StaticOrder, true, true>(lds, g, So, E);
}

typedef const __attribute__((address_space(4))) unsigned char* kargp_t;
__device__ __forceinline__ const float* karg_in(int i) { kargp_t kp = (kargp_t)__builtin_amdgcn_kernarg_segment_ptr(); return (const float*)*(const unsigned long long volatile __attribute__((address_space(4)))*)(kp + 8 * i); }
#define INP(i) karg_in(i)
#define XOUT ((float*)karg_in(26))
#define WSB ((unsigned char*)karg_in(27))
#define TIDS() int tid_ = threadIdx.x; asm volatile("" : "+v"(tid_)); const int tid = tid_, lane = tid & 63, wave = __builtin_amdgcn_readfirstlane(tid >> 6); \
    const int gt = blockIdx.x * 512 + tid, GT = gridDim.x * 512, gw = gt >> 6, GW = GT >> 6; (void)lane; (void)wave; (void)gt; (void)GT; (void)gw; (void)GW
#define WP(off) ((bf16_t*)(WSB + WS_W + (off)))

__global__ void __launch_bounds__(512, 2) fwd_kernel(Args a) {
    extern __shared__ __attribute__((aligned(16))) unsigned char lds_raw[];
    cg::grid_group grid = cg::this_grid();
    LAS unsigned char* lds = (LAS unsigned char*)lds_raw;

    { TIDS();
      const float* xin = INP(0); float* X = XOUT; unsigned char* ws = WSB; bf16_t* xb = (bf16_t*)(ws + WS_XB); bf16_t* memb = (bf16_t*)(ws + WS_MEMB);
      float* cosA = (float*)(ws + WS_COSA); float* sinA = (float*)(ws + WS_SINA); float* tabB = (float*)(ws + WS_TABB);
      for (int i = gt; i < T * D / 4; i += GT) { const f32x4 v = ((const f32x4*)xin)[i]; ((f32x4*)X)[i] = v;
          ((unsigned long long*)xb)[i] = (unsigned long long)pg8::pk2(v.x, v.y) | ((unsigned long long)pg8::pk2(v.z, v.w) << 32); }
      const float* mem = INP(1);
      for (int i = gt; i < NB * MEM * D / 4; i += GT) { const f32x4 v = ((const f32x4*)mem)[i];
          ((unsigned long long*)memb)[i] = (unsigned long long)pg8::pk2(v.x, v.y) | ((unsigned long long)pg8::pk2(v.z, v.w) << 32); }
      for (int i = gt; i < S * 32; i += GT) { const int s = i >> 5, k = i & 31; const float inv = powf(10000.0f, -(float)k * (1.0f / 32.0f)); const float ang = (float)s * inv; cosA[i] = cosf(ang); sinA[i] = sinf(ang); }
      for (int i = gt; i < 64 * 16; i += GT) { const int p = i >> 4, k = i & 15; const float inv = powf(10000.0f, -(float)k * (1.0f / 16.0f)); const float ang = (float)p * inv; tabB[i] = cosf(ang); tabB[1024 + i] = sinf(ang); }
    }

    for (int l = 0; l < DEPTH; ++l) {
        asm volatile("" : "+s"(l));
        { TIDS(); LAS float* scr = (LAS float*)(lds + wave * 16384);
          transpose_mat(INP(2) + (size_t)l * D * DIN, D, DIN, WP(W_IN), scr, gw, GW, lane);
          for (int n = 0; n < 3; ++n) transpose_mat(INP(11) + ((size_t)l * 3 + n) * 512 * D, 512, D, WP(W_BR) + (size_t)n * D * 512, scr, gw, GW, lane);
          transpose_mat(INP(12) + (size_t)l * D * D, D, D, WP(W_MIX), scr, gw, GW, lane);
          transpose_mat(INP(15) + (size_t)l * D * 512, D, 512, WP(W_Q), scr, gw, GW, lane);
          transpose_mat(INP(16) + (size_t)l * D * D, D, D, WP(W_KV), scr, gw, GW, lane);
          transpose_mat(INP(17) + (size_t)l * 512 * D, 512, D, WP(W_O), scr, gw, GW, lane);
          transpose_mat(INP(20) + (size_t)l * D * DIN, D, DIN, WP(W_UP), scr, gw, GW, lane);
          transpose_mat(INP(23) + (size_t)l * DFF * D, DFF, D, WP(W_DN), scr, gw, GW, lane); }
        grid.sync();
        run_gemm(lds, (bf16_t*)(WSB + WS_XB), WP(W_IN), T, DIN, D, pg8::FStoreBf16{(bf16_t*)(WSB + WS_R1), DIN, 1.0f});
        grid.sync();
        { TIDS(); unsigned char* ws = WSB;
          prep_phase((bf16_t*)(ws + WS_R1), INP(3) + (size_t)l * 3072, INP(5) + l * 64, INP(6) + l * 64, INP(7) + l * 512, INP(8) + l * 512,
                     (const float*)(ws + WS_COSA), (const float*)(ws + WS_SINA), (const float*)(ws + WS_TABB), gt, GT);
          make_vt((bf16_t*)(ws + WS_R1), (bf16_t*)(ws + WS_R2 + R2_VT), gt, GT); }
        grid.sync();
        { TIDS(); unsigned char* ws = WSB; bf16_t* proj = (bf16_t*)(ws + WS_R1); bf16_t* br = (bf16_t*)(ws + WS_R2 + R2_BR);
          const bf16_t* vt = (const bf16_t*)(ws + WS_R2 + R2_VT);
          for (int u = blockIdx.x; u < 512; u += gridDim.x) {
              const int qb = u & 15, h = (u >> 4) & 7, b = u >> 7, kvh = h >> 2;
              fa_unit<64, false>(lds, proj + C_BQ + (size_t)(b * S + 256 * qb) * DIN + h * 64, DIN, proj + C_BK + (size_t)(b * S) * DIN + kvh * 64, DIN,
                                 vt + (size_t)NB * 2 * 64 * S + (size_t)((b * 2 + kvh) * 64) * S, S, br + (size_t)T * 512 + (size_t)(b * S + 256 * qb) * 512 + h * 64, 512, 0, 63, 256 * qb, 0.125f * 1.4426950408889634f, 0.f);
          }
          for (int u = blockIdx.x; u < 512; u += gridDim.x) {
              const int qb = u & 15, h = (u >> 4) & 7, b = u >> 7, kvh = h >> 2;
              const int tlo = 4 * qb - 2 < 0 ? 0 : 4 * qb - 2, thi = 4 * qb + 5 > 63 ? 63 : 4 * qb + 5;
              const float sk = (INP(4) + l * 8)[h] * 1.4426950408889634f;
              fa_unit<64, true>(lds, proj + C_AQ + (size_t)(b * S + 256 * qb) * DIN + h * 64, DIN, proj + C_AK + (size_t)(b * S) * DIN + kvh * 64, DIN,
                                vt + (size_t)((b * 2 + kvh) * 64) * S, S, br + (size_t)(b * S + 256 * qb) * 512 + h * 64, 512, tlo, thi, 256 * qb, 0.125f * 1.4426950408889634f, sk);
          }
          naive_gmlp(proj, INP(9) + (size_t)l * 4 * 128 * 128, INP(10) + l * 512, br + (size_t)2 * T * 512, gt, GT); }
        grid.sync();
        for (int n = 0; n < 3; ++n) {
            asm volatile("" : "+s"(n));
            run_gemm(lds, (bf16_t*)(WSB + WS_R2 + R2_BR) + (size_t)n * T * 512, WP(W_BR) + (size_t)n * D * 512, T, D, 512,
                     pg8::FBranch{(bf16_t*)(WSB + WS_R2 + R2_MERGED), (bf16_t*)(WSB + WS_R1) + C_G + n * 1024, DIN, n == 0 ? 1 : 0});
        }
        grid.sync();
        run_gemm(lds, (bf16_t*)(WSB + WS_R2 + R2_MERGED), WP(W_MIX), T, D, D, pg8::FResid{XOUT, (float*)(WSB + WS_R1), ALPHA});
        grid.sync();
        { TIDS(); ln_phase((float*)(WSB + WS_R1), INP(13) + l * D, INP(14) + l * D, XOUT, (bf16_t*)(WSB + WS_XB), gw, GW, lane); }
        grid.sync();
        run_gemm(lds, (bf16_t*)(WSB + WS_XB), WP(W_Q), T, 512, D, pg8::FStoreBf16{(bf16_t*)(WSB + WS_R2 + R2_XQ), 512, 1.0f});
        run_gemm(lds, (bf16_t*)(WSB + WS_MEMB), WP(W_KV), NB * MEM, D, D, pg8::FStoreKV{(bf16_t*)(WSB + WS_MEMKV), (bf16_t*)(WSB + WS_MEMKV + MiB)});
        grid.sync();
        { unsigned char* ws = WSB; const bf16_t* memk = (const bf16_t*)(ws + WS_MEMKV); const bf16_t* memvt = (const bf16_t*)(ws + WS_MEMKV + MiB);
          const bf16_t* xq = (const bf16_t*)(ws + WS_R2 + R2_XQ); bf16_t* xo = (bf16_t*)(ws + WS_R2 + R2_XO);
          for (int u = blockIdx.x; u < 256; u += gridDim.x) {
              const int qb = u & 63, h = u >> 6, b = qb >> 4;
              fa_unit<128, false>(lds, xq + (size_t)(256 * qb) * 512 + h * 128, 512, memk + (size_t)(b * MEM) * 512 + h * 128, 512,
                                  memvt + (size_t)((b * 4 + h) * 128) * MEM, MEM, xo + (size_t)(256 * qb) * 512 + h * 128, 512, 0, 3, 0, 0.08838834764831845f * 1.4426950408889634f, 0.f);
          } }
        grid.sync();
        run_gemm(lds, (bf16_t*)(WSB + WS_R2 + R2_XO), WP(W_O), T, D, 512, pg8::FResid{XOUT, (float*)(WSB + WS_R1), ALPHA});
        grid.sync();
        { TIDS(); ln_phase((float*)(WSB + WS_R1), INP(18) + l * D, INP(19) + l * D, XOUT, (bf16_t*)(WSB + WS_XB), gw, GW, lane); }
        grid.sync();
        run_gemm(lds, (bf16_t*)(WSB + WS_XB), WP(W_UP), T, DIN, D, pg8::FStoreBf16{(bf16_t*)(WSB + WS_R1), DIN, 1.0f});
        grid.sync();
        { TIDS(); naive_conv((bf16_t*)(WSB + WS_R1), INP(21) + (size_t)l * 3 * DIN, INP(22) + (size_t)l * DIN, (bf16_t*)(WSB + WS_R2 + R2_G), gt, GT); }
        grid.sync();
        run_gemm(lds, (bf16_t*)(WSB + WS_R2 + R2_G), WP(W_DN), T, D, DFF, pg8::FResid{XOUT, (float*)(WSB + WS_R1), ALPHA});
        grid.sync();
        { TIDS(); ln_phase((float*)(WSB + WS_R1), INP(24) + l * D, INP(25) + l * D, XOUT, (bf16_t*)(WSB + WS_XB), gw, GW, lane); }
        grid.sync();
    }
}

extern "C" void kernel_launch(void* const* d_in, const int* in_sizes, int n_in, void* d_out, int out_size, void* d_ws, size_t ws_size, hipStream_t stream) {
    static int grid = 0;
    if (grid == 0) {
        if (n_in != 26 || out_size != T * D || ws_size < WS_END) { fprintf(stderr, "kernel_launch: unexpected shapes / workspace (n_in %d out %d ws %zu)\n", n_in, out_size, ws_size); grid = -1; return; }
        int dev = 0, cus = 0, per_cu = 0;
        hipGetDevice(&dev); hipDeviceGetAttribute(&cus, hipDeviceAttributeMultiprocessorCount, dev);
        hipFuncSetAttribute((const void*)fwd_kernel, hipFuncAttributeMaxDynamicSharedMemorySize, LDS_BYTES);
        hipOccupancyMaxActiveBlocksPerMultiprocessor(&per_cu, (const void*)fwd_kernel, 512, LDS_BYTES);
        if (per_cu < 1) per_cu = 1;
        (void)hipGetLastError();
        grid = cus * per_cu;
    }
    if (grid < 0) return;
    Args a{};
    for (int i = 0; i < 26; ++i) a.in[i] = (const float*)d_in[i];
    a.out = (float*)d_out; a.ws = (unsigned char*)d_ws;
    void* args[] = {&a};
    hipError_t e = hipLaunchCooperativeKernel((const void*)fwd_kernel, dim3(grid), dim3(512), args, LDS_BYTES, stream);
    if (e != hipSuccess) fprintf(stderr, "cooperative launch failed: %s (grid %d)\n", hipGetErrorString(e), grid);
}
```
